# Optimizing an MI355X kernel written in HIP

```python
import math
import jax, jax.numpy as jnp
from jax import lax
import numpy as np

D_MODEL = 1024
BATCH = 8
SEQ = 4096
DEPTH = 4

CHUNK = 64
Q_BLOCK = 128
N_A_LAYERS = DEPTH // 2
N_B_LAYERS = DEPTH - N_A_LAYERS
RWKV_HEAD = 64
RWKV_HEADS = D_MODEL // RWKV_HEAD
DECAY_LORA = 64
ICLR_LORA = 64
GATE_LORA = 160
LNX_EPS = 64e-5
MLA_HEADS = 16
QK_NOPE = 64
QK_ROPE = 32
V_HEAD = 64
Q_LORA = 384
KV_LORA = 256
ROPE_THETA = 10000.0
NEG_INF = -1e30
D_FF = 2816
CONV_W = 3
NORM_EPS = 1e-6

kernel_name = "rwkv7_yoco_mla_convffn_trunk"


def rmsnorm(x, g):
    xf = x.astype(jnp.float32)
    y = xf * lax.rsqrt(jnp.mean(xf * xf, axis=-1, keepdims=True) + NORM_EPS)
    return (y * g.astype(jnp.float32)).astype(x.dtype)


def conv_ffn(x, w_in, conv_w, conv_b, w_out):
    T = x.shape[1]
    gate, up = jnp.split(x @ w_in, 2, axis=-1)
    gp = jnp.pad(gate, ((0, 0), (CONV_W - 1, 0), (0, 0)))
    gc = conv_b
    for j in range(CONV_W):
        gc = gc + gp[:, j:j + T, :] * conv_w[j]
    h = jax.nn.gelu(gc) * up
    return h @ w_out


def _rwkv7_step(S, inp):
    r, w, k, v, a, b = inp
    sa = jnp.einsum('bhvk,bhk->bhv', S, a)
    S = S * w[:, :, None, :] + sa[..., None] * b[:, :, None, :] + v[..., None] * k[:, :, None, :]
    y = jnp.einsum('bhvk,bhk->bhv', S, r)
    return S, y


def rwkv7_time_mix(x, mu, w_rkv, w0, w1, w2, a0, a1, a2, g1, g2, k_k, k_a, r_k, lnx_w, lnx_b, w_o):
    B, T, D = x.shape
    H, N = RWKV_HEADS, RWKV_HEAD
    f32 = jnp.float32
    x_prev = jnp.pad(x, ((0, 0), (1, 0), (0, 0)))[:, :T]
    xx = x_prev - x
    xs = x[None] + xx[None] * mu[:, None, None, :]
    rkv = jnp.einsum('nbtd,nde->nbte', xs[:3], w_rkv)
    r, k, v = rkv[0], rkv[1], rkv[2]
    xw, xa, xg = xs[3], xs[4], xs[5]
    w_log = -jax.nn.softplus(-(w0 + jnp.tanh(xw @ w1) @ w2)) - 0.5
    decay = jnp.exp(-jnp.exp(w_log.astype(f32)))
    a = jax.nn.sigmoid(a0 + (xa @ a1) @ a2)
    g = jax.nn.sigmoid(xg @ g1) @ g2
    kk = (k * k_k).reshape(B, T, H, N).astype(f32)
    kk = kk / jnp.maximum(jnp.sqrt(jnp.sum(kk * kk, axis=-1, keepdims=True)), 1e-12)
    k = k * (1.0 + (a - 1.0) * k_a)
    heads = lambda t: t.reshape(B, T, H, N).astype(f32)
    rh, kh, vh, wh, ah = heads(r), heads(k), heads(v), heads(decay), heads(a)
    seq = tuple(jnp.moveaxis(t, 1, 0) for t in (rh, wh, kh, vh, -kk, kk * ah))
    S0 = jnp.zeros((B, H, N, N), f32)
    _, y = lax.scan(_rwkv7_step, S0, seq)
    y = jnp.moveaxis(y, 0, 1)
    mean = jnp.mean(y, axis=-1, keepdims=True)
    var = jnp.mean(jnp.square(y - mean), axis=-1, keepdims=True)
    yn = ((y - mean) * lax.rsqrt(var + LNX_EPS)).reshape(B, T, D) * lnx_w + lnx_b
    bonus = (jnp.sum(rh * kh * r_k, axis=-1, keepdims=True) * vh).reshape(B, T, D)
    out = ((yn + bonus) * g).astype(x.dtype)
    return out @ w_o


def rope_tables(T):
    inv = 1.0 / (ROPE_THETA ** (jnp.arange(0, QK_ROPE, 2, dtype=jnp.float32) / QK_ROPE))
    ang = jnp.arange(T, dtype=jnp.float32)[:, None] * inv[None, :]
    return jnp.cos(ang), jnp.sin(ang)


def apply_rope(x, cos, sin):
    half = x.shape[-1] // 2
    xf = x.astype(jnp.float32)
    x1, x2 = xf[..., :half], xf[..., half:]
    return jnp.concatenate([x1 * cos - x2 * sin, x1 * sin + x2 * cos], axis=-1).astype(x.dtype)


def mla_attend(q_nope, q_rope, k_nope, k_rope, v):
    B, T, H, _ = q_nope.shape
    nb = T // Q_BLOCK
    scale = 1.0 / math.sqrt(QK_NOPE + QK_ROPE)
    k_chunk = jnp.arange(T) // CHUNK

    def blocks(t):
        return jnp.moveaxis(t.reshape((B, nb, Q_BLOCK) + t.shape[2:]), 1, 0)

    def one_block(args):
        qn, qr, bi = args
        s = jnp.einsum('bqhd,bkhd->bhqk', qn, k_nope) + jnp.einsum('bqhr,bkr->bhqk', qr, k_rope)
        s = s.astype(jnp.float32) * scale
        q_chunk = (bi * Q_BLOCK + jnp.arange(Q_BLOCK)) // CHUNK
        mask = k_chunk[None, :] <= q_chunk[:, None]
        s = jnp.where(mask[None, None], s, NEG_INF)
        p = jax.nn.softmax(s, axis=-1)
        return jnp.einsum('bhqk,bkhd->bqhd', p.astype(v.dtype), v)

    out = lax.map(one_block, (blocks(q_nope), blocks(q_rope), jnp.arange(nb)))
    return jnp.moveaxis(out, 0, 1).reshape(B, T, H, V_HEAD)


def setup_inputs(seed: int = 0) -> dict:
    key = jax.random.key(seed)
    ks = jax.random.split(key, 32)
    D, F, H, N = D_MODEL, D_FF, RWKV_HEADS, RWKV_HEAD
    nA, nB = N_A_LAYERS, N_B_LAYERS
    nrm = lambda k, shape, s: jax.random.normal(k, shape, jnp.float32) * s
    return {
        'x': nrm(ks[0], (BATCH, SEQ, D), 1.0),
        'norm_g': 1.0 + nrm(ks[1], (DEPTH, 4, D), 0.05),
        'ffn_w_in': nrm(ks[2], (DEPTH, D, 2 * F), D ** -0.5),
        'ffn_conv_w': nrm(ks[3], (DEPTH, CONV_W, F), CONV_W ** -0.5),
        'ffn_conv_b': nrm(ks[4], (DEPTH, F), 0.01),
        'ffn_w_out': nrm(ks[5], (DEPTH, F, D), F ** -0.5),
        'a_mu': jax.random.uniform(ks[6], (nA, 6, D), jnp.float32),
        'a_w_rkv': nrm(ks[7], (nA, 3, D, D), D ** -0.5),
        'a_w0': jax.random.uniform(ks[8], (nA, D), jnp.float32, minval=-6.5, maxval=-1.5),
        'a_w1': nrm(ks[9], (nA, D, DECAY_LORA), 0.1 * D ** -0.5),
        'a_w2': nrm(ks[10], (nA, DECAY_LORA, D), DECAY_LORA ** -0.5),
        'a_a0': nrm(ks[11], (nA, D), 0.1),
        'a_a1': nrm(ks[12], (nA, D, ICLR_LORA), 0.1 * D ** -0.5),
        'a_a2': nrm(ks[13], (nA, ICLR_LORA, D), ICLR_LORA ** -0.5),
        'a_g1': nrm(ks[14], (nA, D, GATE_LORA), D ** -0.5),
        'a_g2': nrm(ks[15], (nA, GATE_LORA, D), GATE_LORA ** -0.5),
        'a_k_k': 0.85 + nrm(ks[16], (nA, D), 0.05),
        'a_k_a': 1.0 + nrm(ks[17], (nA, D), 0.05),
        'a_r_k': nrm(ks[18], (nA, H, N), 0.1),
        'a_lnx_w': 1.0 + nrm(ks[19], (nA, D), 0.05),
        'a_lnx_b': nrm(ks[20], (nA, D), 0.01),
        'a_w_o': nrm(ks[21], (nA, D, D), D ** -0.5),
        'kv_norm_g': 1.0 + nrm(ks[22], (D,), 0.05),
        'kv_w_down': nrm(ks[23], (D, KV_LORA + QK_ROPE), D ** -0.5),
        'kv_a_norm_g': 1.0 + nrm(ks[24], (KV_LORA,), 0.05),
        'kv_w_up': nrm(ks[25], (KV_LORA, MLA_HEADS * (QK_NOPE + V_HEAD)), KV_LORA ** -0.5),
        'q_w_down': nrm(ks[26], (nB, D, Q_LORA), D ** -0.5),
        'q_norm_g': 1.0 + nrm(ks[27], (nB, Q_LORA), 0.05),
        'q_w_up': nrm(ks[28], (nB, Q_LORA, MLA_HEADS * (QK_NOPE + QK_ROPE)), Q_LORA ** -0.5),
        'o_w': nrm(ks[29], (nB, MLA_HEADS * V_HEAD, D), (MLA_HEADS * V_HEAD) ** -0.5),
    }


def reference(x, norm_g, ffn_w_in, ffn_conv_w, ffn_conv_b, ffn_w_out,
              a_mu, a_w_rkv, a_w0, a_w1, a_w2, a_a0, a_a1, a_a2, a_g1, a_g2,
              a_k_k, a_k_a, a_r_k, a_lnx_w, a_lnx_b, a_w_o,
              kv_norm_g, kv_w_down, kv_a_norm_g, kv_w_up,
              q_w_down, q_norm_g, q_w_up, o_w):
    B, T, _ = x.shape
    cos, sin = rope_tables(T)
    k_nope = k_rope = v_sh = None
    for layer in range(DEPTH):
        h = rmsnorm(x, norm_g[layer, 0])
        if layer < N_A_LAYERS:
            i = layer
            m = rwkv7_time_mix(h, a_mu[i], a_w_rkv[i], a_w0[i], a_w1[i], a_w2[i],
                               a_a0[i], a_a1[i], a_a2[i], a_g1[i], a_g2[i],
                               a_k_k[i], a_k_a[i], a_r_k[i], a_lnx_w[i], a_lnx_b[i], a_w_o[i])
        else:
            if layer == N_A_LAYERS:
                down = rmsnorm(x, kv_norm_g) @ kv_w_down
                c_kv = rmsnorm(down[..., :KV_LORA], kv_a_norm_g)
                k_rope = apply_rope(down[..., KV_LORA:], cos, sin)
                up = (c_kv @ kv_w_up).reshape(B, T, MLA_HEADS, QK_NOPE + V_HEAD)
                k_nope, v_sh = up[..., :QK_NOPE], up[..., QK_NOPE:]
            j = layer - N_A_LAYERS
            c_q = rmsnorm(h @ q_w_down[j], q_norm_g[j])
            q = (c_q @ q_w_up[j]).reshape(B, T, MLA_HEADS, QK_NOPE + QK_ROPE)
            q_nope = q[..., :QK_NOPE]
            q_rope = apply_rope(q[..., QK_NOPE:], cos[:, None, :], sin[:, None, :])
            o = mla_attend(q_nope, q_rope, k_nope, k_rope, v_sh)
            m = o.reshape(B, T, MLA_HEADS * V_HEAD) @ o_w[j]
        x = x + rmsnorm(m, norm_g[layer, 1])
        f = conv_ffn(rmsnorm(x, norm_g[layer, 2]), ffn_w_in[layer], ffn_conv_w[layer],
                     ffn_conv_b[layer], ffn_w_out[layer])
        x = x + rmsnorm(f, norm_g[layer, 3])
    return x
```

```cpp
#include <hip/hip_runtime.h>
#include <cstdio>
#include <cstdint>

#define LAS __attribute__((address_space(3)))
#define GAS __attribute__((address_space(1)))
typedef unsigned short bf16;
typedef float f32x4 __attribute__((ext_vector_type(4)));
typedef unsigned u32x4 __attribute__((ext_vector_type(4)));
typedef unsigned u32x2 __attribute__((ext_vector_type(2)));

#ifndef ONE_LAUNCH
#define ONE_LAUNCH 1
#endif

constexpr int NB = 8, T = 4096, D = 1024, M = NB * T, MH = M / 2, MQ = M / 4, FF = 2816, NH = 16;
constexpr int NTHREADS = 512, NWAVES = 8;
constexpr int LDS_BYTES = 147456;
constexpr float NORM_EPS = 1e-6f, LNX_EPS = 64e-5f;
__device__ __forceinline__ float rs_inv4(const float* part, size_t row) { const f32x4 q = *(const f32x4*)(part + row * 4); return rsqrtf(((q[0] + q[1]) + (q[2] + q[3])) * (1.f / 1024.f) + NORM_EPS); }

constexpr size_t MiB = 1u << 20;
constexpr size_t WS_CTL = 0, CTL_BYTES = 1 * MiB;
constexpr size_t WS_SSQ = 99 * MiB + 640 * 1024;
constexpr size_t WS_COS = 1 * MiB, WS_SIN = WS_COS + 256 * 1024;
constexpr size_t WS_W = 2 * MiB;
constexpr size_t W_RKV = WS_W;
constexpr size_t W_OA = W_RKV + 12 * MiB;
constexpr size_t W_LD = W_OA + 4 * MiB;
constexpr size_t W_W2 = W_LD + 3 * MiB;
constexpr size_t W_A2 = W_W2 + 512 * 1024;
constexpr size_t W_G2 = W_A2 + 512 * 1024;
constexpr size_t W_FIN = W_G2 + 1 * MiB;
constexpr size_t W_FOUT = W_FIN + 44 * MiB;
constexpr size_t W_KVD = W_FOUT + 22 * MiB;
constexpr size_t W_KVUK = W_KVD + 1 * MiB;
constexpr size_t W_KVUV = W_KVUK + 512 * 1024;
constexpr size_t W_QD = W_KVUV + 512 * 1024;
constexpr size_t W_QU = W_QD + 2 * MiB;
constexpr size_t W_OM = W_QU + 2 * MiB + 256 * 1024;
constexpr size_t W_END = W_OM + 4 * MiB;
static_assert(W_END <= 100 * MiB, "weights");
constexpr size_t A_XN = 100 * MiB;
constexpr size_t A_S0 = 164 * MiB;
#define SLOT(i) (A_S0 + (size_t)(i) * 32 * MiB)
constexpr size_t A_KN = 382 * MiB, A_VT = 446 * MiB, A_KR = 510 * MiB, WS_NEED = 512 * MiB;

struct P { const float* in[30]; float* X; unsigned char* ws; int s_lo, s_hi; };

__device__ __forceinline__ unsigned f2bf(float f) { unsigned u = __builtin_bit_cast(unsigned, f); return (u + 0x7fffu + ((u >> 16) & 1u)) >> 16; }
typedef float f32x2_t __attribute__((ext_vector_type(2)));
typedef __bf16 b16x2_t __attribute__((ext_vector_type(2)));
__device__ __forceinline__ unsigned pk2(float lo, float hi) { const f32x2_t v = {lo, hi}; return __builtin_bit_cast(unsigned, __builtin_convertvector(v, b16x2_t)); }
template <int CTRL> __device__ __forceinline__ float dpp_mov0(float v) { const int iv = __builtin_bit_cast(int, v); return __builtin_bit_cast(float, __builtin_amdgcn_update_dpp(0, iv, CTRL, 0xf, 0xf, true)); }
__device__ __forceinline__ float bf2f(unsigned short b) { return __builtin_bit_cast(float, (unsigned)b << 16); }
__device__ __forceinline__ float bflo(unsigned w) { return __builtin_bit_cast(float, w << 16); }
__device__ __forceinline__ float bfhi(unsigned w) { return __builtin_bit_cast(float, w & 0xffff0000u); }
__device__ __forceinline__ float wave_sum(float v) {
#pragma unroll
    for (int o = 1; o < 64; o <<= 1) v += __shfl_xor(v, o);
    return v;
}
template <int CTRL> __device__ __forceinline__ float dpp_mov(float v) { return __builtin_bit_cast(float, __builtin_amdgcn_update_dpp(0, __builtin_bit_cast(int, v), CTRL, 0xf, 0xf, false)); }
__device__ __forceinline__ float red16(float v) { v += dpp_mov<0xB1>(v); v += dpp_mov<0x4E>(v); v += dpp_mov<0x141>(v); v += dpp_mov<0x140>(v); return v; }
__device__ __forceinline__ float wave_sum_dpp(float v) { v = red16(v);
    v += __builtin_bit_cast(float, __builtin_amdgcn_update_dpp(0, __builtin_bit_cast(int, v), 0x142, 0xa, 0xf, false));
    v += __builtin_bit_cast(float, __builtin_amdgcn_update_dpp(0, __builtin_bit_cast(int, v), 0x143, 0xc, 0xf, false));
    return __builtin_bit_cast(float, __builtin_amdgcn_readlane(__builtin_bit_cast(int, v), 63)); }
__device__ __forceinline__ float half_sum_r13(float v) { v = red16(v);
    asm volatile("s_nop 1\n\tv_add_f32_dpp %0, %0, %0 row_bcast:15 row_mask:0xa" : "+v"(v));
    return v; }
__device__ __forceinline__ float wave_sum_l63(float v) { v = red16(v);
    asm volatile("s_nop 1\n\tv_add_f32_dpp %0, %0, %0 row_bcast:15 row_mask:0xa\n\ts_nop 1\n\tv_add_f32_dpp %0, %0, %0 row_bcast:31 row_mask:0xc" : "+v"(v));
    return v; }
__device__ __forceinline__ float sigmoidf_(float x) { return 1.f / (1.f + __expf(-x)); }
__device__ __forceinline__ float gelu_tanh(float x) { const float u = 0.7978845608028654f * (x + 0.044715f * x * x * x); return 0.5f * x * (1.f + tanhf(u)); }

#define XB_TMO      128
#define XB_XCNT(j)  (256  + 64 * (j))
#define XB_XSUB(j)  (1280 + 64 * (j))
#define XB_XGEN(j)  (2304 + 64 * (j))
#define XB_TOP      3328
#define XB_TOPGEN   3392
#define XCD_BAR_WORDS 3456
#define XB_SPIN_CAP (1u << 22)
__device__ __forceinline__ unsigned xb_ld(unsigned* p)              { return __hip_atomic_load(p, __ATOMIC_RELAXED, __HIP_MEMORY_SCOPE_AGENT); }
__device__ __forceinline__ unsigned xb_add(unsigned* p, unsigned v) { return __hip_atomic_fetch_add(p, v, __ATOMIC_RELAXED, __HIP_MEMORY_SCOPE_AGENT); }
__device__ __forceinline__ unsigned xb_xcc_id() { return (unsigned)__builtin_amdgcn_s_getreg((3 << 11) | 20) & 0xFu; }
#define XB_SPIN(cond, bar) do { unsigned _sp = 0; while (cond) { __builtin_amdgcn_s_sleep(1); \
    if ((++_sp & 255u) == 0u) { if (xb_ld(&(bar)[XB_TMO])) break; if (_sp > XB_SPIN_CAP) { atomicAdd(&(bar)[XB_TMO], 1u); break; } } } } while (0)
struct XcdBarrier { unsigned* bar; unsigned x; volatile LAS unsigned* st; };
__device__ __forceinline__ XcdBarrier xcd_barrier_post(unsigned* bar, volatile LAS unsigned* st) {
    XcdBarrier b; b.bar = bar; b.x = xb_xcc_id(); b.st = st;
    if (threadIdx.x == 0) (void)xb_add(&bar[XB_XCNT(b.x)], 1u);
    return b;
}
__device__ __forceinline__ void xcd_barrier_complete(unsigned* bar, unsigned x, unsigned& nloc, unsigned& nx) {
    const unsigned G = gridDim.x * gridDim.y * gridDim.z;
    unsigned sum, cnt, mine, sp = 0u;
    for (;;) {
        sum = 0u; cnt = 0u; mine = 0u;
#pragma unroll
        for (unsigned j = 0; j < 16; ++j) { const unsigned c = xb_ld(&bar[XB_XCNT(j)]); sum += c; cnt += (c > 0u) ? 1u : 0u; mine = (j == x) ? c : mine; }
        if (sum == G) break;
        __builtin_amdgcn_s_sleep(1);
        if ((++sp & 255u) == 0u) { if (xb_ld(&bar[XB_TMO])) break; if (sp > XB_SPIN_CAP) { atomicAdd(&bar[XB_TMO], 1u); break; } }
    }
    nloc = mine > 0u ? mine : 1u; nx = cnt > 0u ? cnt : 1u;
}
__device__ __forceinline__ void xcd_barrier(const XcdBarrier& b) {
    asm volatile("s_waitcnt vmcnt(0)" ::: "memory");
    __syncthreads();
    if (threadIdx.x == 0) {
        unsigned* bar = b.bar;
        __builtin_amdgcn_s_waitcnt(0);
        unsigned nloc = b.st[0], nx = b.st[1];
        if (nloc == 0u) { xcd_barrier_complete(bar, b.x, nloc, nx); b.st[0] = nloc; b.st[1] = nx; }
        const unsigned old = xb_add(&bar[XB_XSUB(b.x)], 1u);
        const unsigned gen = old / nloc;
        if (old + 1u == (gen + 1u) * nloc) {
            __builtin_amdgcn_fence(__ATOMIC_RELEASE, "agent");
            asm volatile("s_waitcnt vmcnt(0)" ::: "memory");
            const unsigned og = xb_add(&bar[XB_TOP], 1u);
            const unsigned tg = og / nx;
            if (og + 1u == (tg + 1u) * nx) xb_add(&bar[XB_TOPGEN], 1u);
            else XB_SPIN(xb_ld(&bar[XB_TOPGEN]) == tg, bar);
            __builtin_amdgcn_fence(__ATOMIC_ACQUIRE, "agent");
            xb_add(&bar[XB_XGEN(b.x)], 1u);
            asm volatile("s_waitcnt vmcnt(0)" ::: "memory");
        } else {
            XB_SPIN(xb_ld(&bar[XB_XGEN(b.x)]) == gen, bar);
            __builtin_amdgcn_fence(__ATOMIC_ACQUIRE, "agent");
            asm volatile("s_waitcnt vmcnt(0)" ::: "memory");
        }
    }
    __syncthreads();
}

struct Fr { LAS unsigned char* lds; int tid, lane, wave, bid, nb, gw, ngw; };

struct TJob { const float* src; int K, ld, ngroups, gw, gstride, goff; bf16* dst; int ldd, Kpad; const float* sc; int scmode; const float* sc2; };
struct TJobL { unsigned long long src, dst, sc, sc2; int K, ld, ngroups, gw, gstride, goff, ldd, Kpad, scmode, first, pad0, pad1; };
static_assert(sizeof(TJobL) == 80, "TJobL");
constexpr int TJ_TAB = 73728, TJ_CNT = TJ_TAB + 64 * 80;
__device__ __forceinline__ void tjob_run(const Fr& F, const TJob& J) {
    if (F.tid == 0) {
        LAS TJobL* jt = (LAS TJobL*)(F.lds + TJ_TAB); LAS int* cnt = (LAS int*)(F.lds + TJ_CNT);
        const int n = cnt[0], first = cnt[1], items = (J.Kpad / 64) * (J.ngroups * J.gw / 32);
        TJobL L; L.src = (unsigned long long)J.src; L.dst = (unsigned long long)J.dst; L.sc = (unsigned long long)J.sc; L.sc2 = (unsigned long long)J.sc2; L.pad0 = 0; L.pad1 = 0; L.K = J.K; L.ld = J.ld; L.ngroups = J.ngroups; L.gw = J.gw; L.gstride = J.gstride; L.goff = J.goff;
        L.ldd = J.ldd; L.Kpad = J.Kpad; L.scmode = J.scmode; L.first = first; { LAS int* dp = (LAS int*)(jt + n); const int* sp = (const int*)&L;
#pragma unroll
            for (int q = 0; q < 20; ++q) dp[q] = sp[q]; } cnt[0] = n + 1; cnt[1] = first + items;
    }
}
__device__ __forceinline__ void tjob_exec(const Fr& F) {
    __syncthreads();
    LAS TJobL* jt = (LAS TJobL*)(F.lds + TJ_TAB); LAS int* cnt = (LAS int*)(F.lds + TJ_CNT);
    const int nj = cnt[0], total = cnt[1], lane = F.lane;
    LAS float* scr = (LAS float*)(F.lds + F.wave * 8448);
#pragma unroll 1
    for (int git = F.gw; git < total; git += F.ngw) {
        int ji = 0;
        for (int q = 1; q < nj; ++q) if (jt[q].first <= git) ji = q;
        ji = __builtin_amdgcn_readfirstlane(ji);
        TJobL J; { const LAS int* sp = (const LAS int*)(jt + ji); int* dp = (int*)&J;
#pragma unroll
            for (int q = 0; q < 20; ++q) dp[q] = __builtin_amdgcn_readfirstlane(sp[q]); }
        const float* Jsrc = (const float*)(const GAS float*)J.src; const float* Jsc = (const float*)(const GAS float*)J.sc; const float* Jsc2 = (const float*)(const GAS float*)J.sc2; bf16* Jdst = (bf16*)(GAS bf16*)J.dst;
        const int it = git - J.first;
        const int Ntot = J.ngroups * J.gw, nblk = Ntot / 32;
        const int kb = it / nblk, nbk = it % nblk, k0 = 64 * kb, n0 = 32 * nbk;
        const int grp = n0 / J.gw, within = n0 % J.gw, col0 = grp * J.gstride + J.goff + within;
#pragma unroll 8
        for (int i = 0; i < 32; ++i) {
            const int kk = 2 * i + (lane >> 5), k = k0 + kk; float v = 0.f;
            if (k < J.K) { v = Jsrc[(size_t)k * J.ld + col0 + (lane & 31)]; if (J.sc) { const float s = Jsc[k]; v *= J.scmode ? s : (1.f - s); } if (J.sc2) v *= Jsc2[k]; }
            scr[kk * 33 + (lane & 31)] = v;
        }
        asm volatile("s_waitcnt lgkmcnt(0)" ::: "memory");
        const int c = lane & 7;
#pragma unroll
        for (int j = 0; j < 4; ++j) { const int n = (lane >> 3) + 8 * j; const LAS float* s = scr + (8 * c) * 33 + n;
            u32x4 o; o.x = pk2(s[0 * 33], s[1 * 33]); o.y = pk2(s[2 * 33], s[3 * 33]); o.z = pk2(s[4 * 33], s[5 * 33]); o.w = pk2(s[6 * 33], s[7 * 33]);
            *(u32x4*)(Jdst + (size_t)(n0 + n) * J.ldd + k0 + 8 * c) = o; }
        asm volatile("s_waitcnt lgkmcnt(0)" ::: "memory");
    }
}
__device__ __forceinline__ TJob mkjob(const float* src, int K, int ld, int N, bf16* dst, int ldd, int Kpad) { TJob j; j.src = src; j.K = K; j.ld = ld; j.ngroups = 1; j.gw = N; j.gstride = 0; j.goff = 0; j.dst = dst; j.ldd = ldd; j.Kpad = Kpad; j.sc = nullptr; j.scmode = 0; j.sc2 = nullptr; return j; }
__device__ __forceinline__ void zero_rows(const Fr& F, bf16* dst, size_t nelem) {
    for (size_t i = ((size_t)F.bid * NTHREADS + F.tid) * 8; i < nelem; i += (size_t)F.nb * NTHREADS * 8) *(u32x4*)(dst + i) = (u32x4){0u, 0u, 0u, 0u};
}
__device__ __forceinline__ unsigned long long ldptr(LAS unsigned long long* t, int k) { const unsigned long long v = t[k]; return ((unsigned long long)(unsigned)__builtin_amdgcn_readfirstlane((int)(unsigned)(v >> 32)) << 32) | (unsigned long long)(unsigned)__builtin_amdgcn_readfirstlane((int)(unsigned)v); }
__device__ __forceinline__ void prologue(const Fr& F, LAS unsigned long long* ptab, unsigned char* ws) {
    if (F.tid == 0) { LAS int* cnt = (LAS int*)(F.lds + TJ_CNT); cnt[0] = 0; cnt[1] = 0; }
    for (int i = 0; i < 2; ++i) {
        for (int n = 0; n < 3; ++n) tjob_run(F, mkjob(((const float*)ldptr(ptab, 7)) + (size_t)(i * 3 + n) * D * D, D, D, D, (bf16*)(ws + W_RKV) + (size_t)(i * 3 + n) * D * D, D, D));
        tjob_run(F, mkjob(((const float*)ldptr(ptab, 21)) + (size_t)i * D * D, D, D, D, (bf16*)(ws + W_OA) + (size_t)i * D * D, D, D));
        bf16* ld = (bf16*)(ws + W_LD) + (size_t)i * 768 * D;
        for (int pq = 0; pq < 2; ++pq) {
            TJob j;
            j = mkjob(((const float*)ldptr(ptab, 9)) + (size_t)i * D * 64, D, 64, 64, ld + (size_t)(pq * 288 + 0) * D, D, D);    j.sc = ((const float*)ldptr(ptab, 6)) + (size_t)(i * 6 + 3) * D; j.scmode = pq; tjob_run(F, j);
            j = mkjob(((const float*)ldptr(ptab, 12)) + (size_t)i * D * 64, D, 64, 64, ld + (size_t)(pq * 288 + 64) * D, D, D);  j.sc = ((const float*)ldptr(ptab, 6)) + (size_t)(i * 6 + 4) * D; j.scmode = pq; tjob_run(F, j);
            j = mkjob(((const float*)ldptr(ptab, 14)) + (size_t)i * D * 160, D, 160, 160, ld + (size_t)(pq * 288 + 128) * D, D, D); j.sc = ((const float*)ldptr(ptab, 6)) + (size_t)(i * 6 + 5) * D; j.scmode = pq; tjob_run(F, j);
        }
        zero_rows(F, ld + (size_t)576 * D, (size_t)192 * D);
        tjob_run(F, mkjob(((const float*)ldptr(ptab, 10)) + (size_t)i * 64 * D, 64, D, D, (bf16*)(ws + W_W2) + (size_t)i * D * 128, 128, 128));
        tjob_run(F, mkjob(((const float*)ldptr(ptab, 13)) + (size_t)i * 64 * D, 64, D, D, (bf16*)(ws + W_A2) + (size_t)i * D * 128, 128, 128));
        tjob_run(F, mkjob(((const float*)ldptr(ptab, 15)) + (size_t)i * 160 * D, 160, D, D, (bf16*)(ws + W_G2) + (size_t)i * D * 256, 256, 256));
        { TJob j = mkjob(((const float*)ldptr(ptab, 26)) + (size_t)i * D * 384, D, 384, 384, (bf16*)(ws + W_QD) + (size_t)i * 512 * D, D, D); j.sc2 = ((const float*)ldptr(ptab, 1)) + (size_t)((2 + i) * 4) * D; tjob_run(F, j); }
        zero_rows(F, (bf16*)(ws + W_QD) + (size_t)i * 512 * D + (size_t)384 * D, (size_t)128 * D);
        { TJob j = mkjob(((const float*)ldptr(ptab, 28)) + (size_t)i * 384 * 1536, 384, 1536, 1536, (bf16*)(ws + W_QU) + (size_t)i * 1536 * 384, 384, 384); j.sc2 = ((const float*)ldptr(ptab, 27)) + (size_t)i * 384; tjob_run(F, j); }
        tjob_run(F, mkjob(((const float*)ldptr(ptab, 29)) + (size_t)i * D * D, D, D, D, (bf16*)(ws + W_OM) + (size_t)i * D * D, D, D));
    }
    for (int l = 0; l < 4; ++l) {
        { TJob j = mkjob(((const float*)ldptr(ptab, 2)) + (size_t)l * D * 2 * FF, D, 2 * FF, 2 * FF, (bf16*)(ws + W_FIN) + (size_t)l * 2 * FF * D, D, D); j.sc2 = ((const float*)ldptr(ptab, 1)) + (size_t)(l * 4 + 2) * D; tjob_run(F, j); }
        tjob_run(F, mkjob(((const float*)ldptr(ptab, 5)) + (size_t)l * FF * D, FF, D, D, (bf16*)(ws + W_FOUT) + (size_t)l * D * FF, FF, FF));
    }
    { TJob j = mkjob(((const float*)ldptr(ptab, 23)), D, 288, 288, (bf16*)(ws + W_KVD), D, D); j.sc2 = (const float*)ldptr(ptab, 22); tjob_run(F, j); }
    zero_rows(F, (bf16*)(ws + W_KVD) + (size_t)288 * D, (size_t)224 * D);
    { TJob j = mkjob(((const float*)ldptr(ptab, 25)), 256, 2048, 64, (bf16*)(ws + W_KVUK), 256, 256); j.ngroups = 16; j.gstride = 128; j.goff = 0; tjob_run(F, j);
      j.dst = (bf16*)(ws + W_KVUV); j.goff = 64; tjob_run(F, j); }
    tjob_exec(F);
    { float* z = (float*)(ws + WS_SSQ); for (int i = F.bid * NTHREADS + F.tid; i < 3 * M; i += F.nb * NTHREADS) z[i] = 0.f; }
    float* ct = (float*)(ws + WS_COS); float* st = (float*)(ws + WS_SIN);
    for (int i = F.bid * NTHREADS + F.tid; i < T * 16; i += F.nb * NTHREADS) {
        const int t = i >> 4, f = i & 15;
        const float inv = (float)(1.0 / pow(10000.0, (double)(2 * f) / 32.0));
        const float ang = (float)t * inv;
        ct[i] = (float)cos((double)ang); st[i] = (float)sin((double)ang);
    }
}

struct pg8_Unit { int pm, pn; };
struct EpiBf16 { static constexpr bool PERM = true, WHOLE = false; bf16* O; int ldc, nvalid;
    __device__ __forceinline__ void st8(int r, int c, f32x4 a, f32x4 b) const { u32x4 w; w.x = pk2(a[0], a[1]); w.y = pk2(a[2], a[3]); w.z = pk2(b[0], b[1]); w.w = pk2(b[2], b[3]); *(u32x4*)(O + (size_t)r * ldc + c) = w; }
    __device__ __forceinline__ void operator()(int r, int c, f32x4 v) const { u32x2 w; w.x = pk2(v[0], v[1]); w.y = pk2(v[2], v[3]); *(u32x2*)(O + (size_t)r * ldc + c) = w; } };
struct EpiVT { static constexpr bool PERM = true, WHOLE = false; bf16* O;
    __device__ __forceinline__ size_t at(int r, int c) const { return ((((size_t)(r >> 6) * (M / 64) + (c >> 6)) * 64 + (r & 63)) * 64) + (c & 63); }
    __device__ __forceinline__ void st8(int r, int c, f32x4 a, f32x4 b) const { u32x4 w; w.x = pk2(a[0], a[1]); w.y = pk2(a[2], a[3]); w.z = pk2(b[0], b[1]); w.w = pk2(b[2], b[3]); *(u32x4*)(O + at(r, c)) = w; }
    __device__ __forceinline__ void operator()(int r, int c, f32x4 v) const { u32x2 w; w.x = pk2(v[0], v[1]); w.y = pk2(v[2], v[3]); *(u32x2*)(O + at(r, c)) = w; } };
struct EpiF32RS { static constexpr bool PERM = false, WHOLE = false; float* O; int ldc; const float* rs;
    __device__ __forceinline__ void operator()(int r, int c, f32x4 v) const { *(f32x4*)(O + (size_t)r * ldc + c) = v * rs_inv4(rs, (size_t)r); } };
struct EpiCqRaw { static constexpr bool PERM = true, WHOLE = false; bf16* O; const float* rs; float* ssq; int nssq;
    __device__ __forceinline__ void st8(int r, int c, f32x4 a, f32x4 b) const { const float s = rs_inv4(rs, (size_t)r); a = a * s; b = b * s;
        u32x4 w; w.x = pk2(a[0], a[1]); w.y = pk2(a[2], a[3]); w.z = pk2(b[0], b[1]); w.w = pk2(b[2], b[3]); *(u32x4*)(O + (size_t)r * 512 + c) = w;
        if (c < nssq) { const float q = ((a[0] * a[0] + a[1] * a[1]) + (a[2] * a[2] + a[3] * a[3])) + ((b[0] * b[0] + b[1] * b[1]) + (b[2] * b[2] + b[3] * b[3]));
            __hip_atomic_fetch_add(ssq + r, q, __ATOMIC_RELAXED, __HIP_MEMORY_SCOPE_AGENT); } } };
struct EpiF32 { static constexpr bool PERM = false, WHOLE = false; float* O; int ldc, nvalid;
    __device__ __forceinline__ void operator()(int r, int c, f32x4 v) const { *(f32x4*)(O + (size_t)r * ldc + c) = v; } };
struct EpiDecay { static constexpr bool PERM = true, WHOLE = false; bf16* O; const float* w0;
    __device__ __forceinline__ void st8(int r, int c, f32x4 a, f32x4 b) const { const f32x4 wa = *(const f32x4*)(w0 + c), wb = *(const f32x4*)(w0 + c + 4); float o[8];
#pragma unroll
        for (int j = 0; j < 4; ++j) { o[j] = -0.6065306597126334f * __builtin_amdgcn_rcpf(1.f + __builtin_amdgcn_exp2f(-1.4426950408889634f * (wa[j] + a[j]))); o[4 + j] = -0.6065306597126334f * __builtin_amdgcn_rcpf(1.f + __builtin_amdgcn_exp2f(-1.4426950408889634f * (wb[j] + b[j]))); }
        u32x4 w; w.x = pk2(o[0], o[1]); w.y = pk2(o[2], o[3]); w.z = pk2(o[4], o[5]); w.w = pk2(o[6], o[7]); *(u32x4*)(O + (size_t)r * D + c) = w; } };
struct EpiSigB { static constexpr bool PERM = true, WHOLE = false; bf16* O; const float* a0;
    __device__ __forceinline__ void st8(int r, int c, f32x4 a, f32x4 b) const { const f32x4 wa = *(const f32x4*)(a0 + c), wb = *(const f32x4*)(a0 + c + 4); float o[8];
#pragma unroll
        for (int j = 0; j < 4; ++j) { o[j] = __builtin_amdgcn_rcpf(1.f + __builtin_amdgcn_exp2f(-1.4426950408889634f * (wa[j] + a[j]))); o[4 + j] = __builtin_amdgcn_rcpf(1.f + __builtin_amdgcn_exp2f(-1.4426950408889634f * (wb[j] + b[j]))); }
        u32x4 w; w.x = pk2(o[0], o[1]); w.y = pk2(o[2], o[3]); w.z = pk2(o[4], o[5]); w.w = pk2(o[6], o[7]); *(u32x4*)(O + (size_t)r * D + c) = w; } };
struct EpiQRope { static constexpr bool PERM = false, WHOLE = true; bf16* O; const float* ct; const float* st; int tok0; const float* ssq;
    __device__ __forceinline__ void tile(const f32x4 (&acc)[2][2][4][2], const pg8_Unit& u, int wr, int wc, int fr, int fq) const {
        const float sc = 0.1472444460259031f;
#pragma unroll
        for (int bj = 0; bj < 2; ++bj) {
            const int col = u.pn * 256 + bj * 128 + wc * 32 + 4 * fq; const bool rope = ((col >> 5) % 3) == 2;
#pragma unroll
            for (int ai = 0; ai < 2; ++ai)
#pragma unroll
                for (int m = 0; m < 4; ++m) {
                    const int row = u.pm * 256 + ai * 128 + wr * 64 + m * 16 + fr; f32x4 x1 = acc[ai][bj][m][0], x2 = acc[ai][bj][m][1];
                    if (rope) { const int t = (tok0 + row) % T; const f32x4 cs = *(const f32x4*)(ct + t * 16 + 4 * fq), sn = *(const f32x4*)(st + t * 16 + 4 * fq);
                        const f32x4 y1 = x1 * cs - x2 * sn, y2 = x1 * sn + x2 * cs; x1 = y1; x2 = y2; }
                    const float rq = sc * rsqrtf(ssq[row] * (1.f / 384.f) + NORM_EPS); x1 = x1 * rq; x2 = x2 * rq;
                    u32x2 w1, w2; w1.x = pk2(x1[0], x1[1]); w1.y = pk2(x1[2], x1[3]); w2.x = pk2(x2[0], x2[1]); w2.y = pk2(x2[2], x2[3]);
                    GAS bf16* op = (GAS bf16*)O + (size_t)row * 1536 + col; *(GAS u32x2*)op = w1; *(GAS u32x2*)(op + 16) = w2;
                }
        }
    } };
struct EpiFfn { static constexpr bool PERM = true, WHOLE = true; bf16* H; const float* cw; const float* cb; const float* Gh; const float* rs;
    __device__ __forceinline__ void tile(f32x4 (&acc)[2][2][4][2], const pg8_Unit& u, int wr, int wc, int fr, int fq) const {
        const int tb = u.pm * 256 + wr * 128 + fr * 8, f0 = u.pn * 128 + wc * 32 + fq * 8, grp = u.pm * 2 + wr; const bool seq0 = ((grp * 128) % T) == 0;
        { f32x4 ra, rb;
#pragma unroll
          for (int e = 0; e < 4; ++e) { ra[e] = rs_inv4(rs, (size_t)(tb + e)); rb[e] = rs_inv4(rs, (size_t)(tb + 4 + e)); }
#pragma unroll
          for (int m = 0; m < 4; ++m)
#pragma unroll
            for (int bj = 0; bj < 2; ++bj)
#pragma unroll
              for (int n = 0; n < 2; ++n) { acc[0][bj][m][n] = acc[0][bj][m][n] * ra[m]; acc[1][bj][m][n] = acc[1][bj][m][n] * rb[m]; } }
        f32x4 h2[2], h1[2];
#pragma unroll
        for (int n = 0; n < 2; ++n) { h2[n] = (f32x4){0.f, 0.f, 0.f, 0.f}; h1[n] = h2[n]; }
        if (fr == 0 && !seq0) { const float r2 = rs_inv4(rs, (size_t)(tb - 2)), r1 = rs_inv4(rs, (size_t)(tb - 1));
#pragma unroll
            for (int n = 0; n < 2; ++n) { h2[n] = *(const GAS f32x4*)((const GAS float*)Gh + (size_t)(2 * grp) * FF + f0 + 4 * n) * r2; h1[n] = *(const GAS f32x4*)((const GAS float*)Gh + (size_t)(2 * grp + 1) * FF + f0 + 4 * n) * r1; }
        }
#pragma unroll
        for (int n = 0; n < 2; ++n) {
            const f32x4 c0 = *(const f32x4*)(cw + f0 + 4 * n), c1 = *(const f32x4*)(cw + FF + f0 + 4 * n), c2 = *(const f32x4*)(cw + 2 * FF + f0 + 4 * n), bv = *(const f32x4*)(cb + f0 + 4 * n);
            f32x4 gm1, gm2;
#pragma unroll
            for (int e = 0; e < 4; ++e) {
                const float a7 = acc[1][0][3][n][e], a6 = acc[1][0][2][n][e];
                const float t1 = dpp_mov0<0x111>(a7), t2 = dpp_mov0<0x111>(a6);
                gm1[e] = fr > 0 ? t1 : h1[n][e]; gm2[e] = fr > 0 ? t2 : h2[n][e]; }
#pragma unroll
            for (int idx = 7; idx >= 0; --idx) {
                const f32x4 g0 = acc[idx >> 2][0][idx & 3][n];
                const f32x4 p1 = idx >= 1 ? acc[(idx - 1) >> 2][0][(idx - 1) & 3][n] : gm1;
                const f32x4 p2 = idx >= 2 ? acc[(idx - 2) >> 2][0][(idx - 2) & 3][n] : (idx == 1 ? gm1 : gm2);
                const f32x4 gc = bv + p2 * c0 + p1 * c1 + g0 * c2, up = acc[idx >> 2][1][idx & 3][n];
                f32x4 hv;
#pragma unroll
                for (int e = 0; e < 4; ++e) { const float x = gc[e];
                    const float ex = __builtin_amdgcn_exp2f(x * __builtin_fmaf(x * x, -0.10294324f, -2.3022082f)); hv[e] = x * up[e] * __builtin_amdgcn_rcpf(1.f + ex); }
                acc[idx >> 2][0][idx & 3][n] = hv;
            }
        }
#pragma unroll
        for (int idx = 0; idx < 8; ++idx) { const f32x4 a = acc[idx >> 2][0][idx & 3][0], b = acc[idx >> 2][0][idx & 3][1];
            u32x4 w; w.x = pk2(a[0], a[1]); w.y = pk2(a[2], a[3]); w.z = pk2(b[0], b[1]); w.w = pk2(b[2], b[3]);
            *(GAS u32x4*)((GAS bf16*)H + (size_t)(tb + idx) * FF + f0) = w; }
    } };
constexpr size_t WS_RCNT = 32 * 1024;
constexpr size_t WS_SSQX = 64 * 1024;
constexpr size_t WS_RSLOT = 1 * MiB + 512 * 1024;
template <bool SF32, bool DF32, bool SQ> struct EpiResid { static constexpr bool PERM = true, WHOLE = true;
    const void* Xs; void* Xd; const float* g; float* slots; unsigned* cnt; unsigned want; float* ssq; LAS unsigned char* lds;
    __device__ __forceinline__ void tile(f32x4 (&acc)[2][2][4][2], const pg8_Unit& u, int wr, int wc, int fr, int fq) const {
        LAS float* P = (LAS float*)(lds + 131072); LAS float* S = P + 1024;
        const int wid = wr * 4 + wc, lane = fq * 16 + fr;
        u32x4 xw[4][2]; f32x4 gv[2][2];
#define ER_LOADX(idx_) do { if (!SF32) { _Pragma("unroll") for (int bj = 0; bj < 2; ++bj) \
            xw[(idx_) & 3][bj] = *(const GAS u32x4*)((const GAS bf16*)Xs + (size_t)(u.pm * 256 + ((idx_) >> 2) * 128 + wr * 64 + ((idx_) & 3) * 16 + fr) * D + u.pn * 256 + bj * 128 + wc * 32 + 8 * fq); } } while (0)
        ER_LOADX(0); ER_LOADX(1); ER_LOADX(2); ER_LOADX(3);
#pragma unroll
        for (int bj = 0; bj < 2; ++bj)
#pragma unroll
            for (int n = 0; n < 2; ++n) gv[bj][n] = *(const GAS f32x4*)((const GAS float*)g + u.pn * 256 + bj * 128 + wc * 32 + 8 * fq + 4 * n);
#pragma unroll
        for (int ai = 0; ai < 2; ++ai)
#pragma unroll
            for (int m = 0; m < 4; ++m) { float q = 0.f;
#pragma unroll
                for (int bj = 0; bj < 2; ++bj)
#pragma unroll
                    for (int n = 0; n < 2; ++n) { const f32x4 x = acc[ai][bj][m][n]; q += (x[0] * x[0] + x[1] * x[1]) + (x[2] * x[2] + x[3] * x[3]); }
                q += __shfl_xor(q, 16); q += __shfl_xor(q, 32);
                if (fq == 0) P[(ai * 128 + wr * 64 + m * 16 + fr) * 4 + wc] = q; }
        asm volatile("s_waitcnt lgkmcnt(0)" ::: "memory"); __builtin_amdgcn_s_barrier(); asm volatile("" ::: "memory");
        const int row = wid * 32 + (lane & 31);
        if (lane < 32) { const f32x4 pq = *(const LAS f32x4*)(P + row * 4);
            __hip_atomic_store(slots + ((size_t)(u.pm * 256 + row) * 4 + u.pn), (pq[0] + pq[1]) + (pq[2] + pq[3]), __ATOMIC_RELAXED, __HIP_MEMORY_SCOPE_AGENT); }
        asm volatile("s_waitcnt vmcnt(0)" ::: "memory");
        if (lane == 0) __hip_atomic_fetch_add(cnt + 64 * u.pm, 1u, __ATOMIC_RELAXED, __HIP_MEMORY_SCOPE_AGENT);
        if (wid == 0) { unsigned sp = 0;
            while ((unsigned)__builtin_amdgcn_readfirstlane((int)__hip_atomic_load(cnt + 64 * u.pm, __ATOMIC_RELAXED, __HIP_MEMORY_SCOPE_AGENT)) < want) { __builtin_amdgcn_s_sleep(2); if (++sp > (1u << 22)) break; }
            __builtin_amdgcn_fence(__ATOMIC_ACQUIRE, "agent"); }
        asm volatile("s_waitcnt vmcnt(0) lgkmcnt(0)" ::: "memory"); __builtin_amdgcn_s_barrier(); asm volatile("" ::: "memory");
        if (lane < 32) { const float* sl = slots + (size_t)(u.pm * 256 + row) * 4; float t = 0.f;
#pragma unroll
            for (int k = 0; k < 4; ++k) t += __hip_atomic_load(sl + k, __ATOMIC_RELAXED, __HIP_MEMORY_SCOPE_AGENT);
            S[row] = rsqrtf(t * (1.f / D) + NORM_EPS); }
        asm volatile("s_waitcnt vmcnt(0) lgkmcnt(0)" ::: "memory"); __builtin_amdgcn_s_barrier(); asm volatile("" ::: "memory");
#pragma unroll
        for (int ai = 0; ai < 2; ++ai) {
#pragma unroll
            for (int m = 0; m < 4; ++m) { const int rl = ai * 128 + wr * 64 + m * 16 + fr; const float ri = S[rl]; const size_t r = (size_t)(u.pm * 256 + rl); float q2 = 0.f;
                u32x4 xc[2]; xc[0] = xw[m][0]; xc[1] = xw[m][1];
                if (ai == 0) { asm volatile("" : "+v"(xc[0]), "+v"(xc[1])); ER_LOADX(4 + m); }
#pragma unroll
                for (int bj = 0; bj < 2; ++bj) { const size_t off = r * D + u.pn * 256 + bj * 128 + wc * 32 + 8 * fq;
                    f32x4 xa, xb;
                    if (SF32) { xa = *(const GAS f32x4*)((const GAS float*)Xs + off); xb = *(const GAS f32x4*)((const GAS float*)Xs + off + 4); }
                    else { const u32x4 xv = xc[bj]; xa = (f32x4){bflo(xv.x), bfhi(xv.x), bflo(xv.y), bfhi(xv.y)}; xb = (f32x4){bflo(xv.z), bfhi(xv.z), bflo(xv.w), bfhi(xv.w)}; }
                    const f32x4 ya = xa + acc[ai][bj][m][0] * ri * gv[bj][0], yb = xb + acc[ai][bj][m][1] * ri * gv[bj][1];
                    if (SQ) q2 += ((ya[0] * ya[0] + ya[1] * ya[1]) + (ya[2] * ya[2] + ya[3] * ya[3])) + ((yb[0] * yb[0] + yb[1] * yb[1]) + (yb[2] * yb[2] + yb[3] * yb[3]));
                    if (DF32) { *(GAS f32x4*)((GAS float*)Xd + off) = ya; *(GAS f32x4*)((GAS float*)Xd + off + 4) = yb; }
                    else { u32x4 w; w.x = pk2(ya[0], ya[1]); w.y = pk2(ya[2], ya[3]); w.z = pk2(yb[0], yb[1]); w.w = pk2(yb[2], yb[3]); *(GAS u32x4*)((GAS bf16*)Xd + off) = w; } }
                if (SQ) { q2 += __shfl_xor(q2, 16); q2 += __shfl_xor(q2, 32); if (fq == 0) P[rl * 4 + wc] = q2; } } }
#undef ER_LOADX
        if (SQ) {
            asm volatile("s_waitcnt lgkmcnt(0)" ::: "memory"); __builtin_amdgcn_s_barrier(); asm volatile("" ::: "memory");
            if (lane < 32) { const f32x4 pq = *(const LAS f32x4*)(P + row * 4); *(GAS float*)((GAS float*)ssq + ((size_t)(u.pm * 256 + row) * 4 + u.pn)) = (pq[0] + pq[1]) + (pq[2] + pq[3]); }
            asm volatile("s_waitcnt lgkmcnt(0)" ::: "memory"); __builtin_amdgcn_s_barrier(); asm volatile("" ::: "memory");
        }
    } };
namespace pg8 {
typedef short bf16x8 __attribute__((ext_vector_type(8)));
constexpr int BM = 256, BK = 64, HALF = 128, HTB = HALF * BK * 2, STAGE_BYTES = 8 * HTB, NXCD = 8, WGM = 8;
__host__ __device__ __forceinline__ int lds_byte(int r, int c) { const int st = (r >> 4) * 2 + (c >> 5), rr = r & 15, cc = c & 31, ob = rr * 64 + cc * 2; return st * 1024 + (ob ^ (((ob >> 9) & 1) << 5)); }
__host__ __device__ __forceinline__ void stage_rc(int b, int& R, int& C) { const int st = b / 1024, sb = b % 1024, swz = sb ^ (((sb >> 9) & 1) << 5); R = (st >> 1) * 16 + swz / 64; C = (st & 1) * 32 + (swz % 64) / 2; }
__host__ __device__ __forceinline__ int perm32(int rho) { const int n = rho >> 4, i = rho & 15; return 8 * (i >> 2) + 4 * n + (i & 3); }
typedef ::pg8_Unit Unit;
struct Gemm { const bf16* A; const bf16* Bt; int M, N, K, lda, ldb; size_t tA, hA, tB, hB; };
template <int AMAP> __device__ __forceinline__ int amap_row(int R) { if (AMAP == 1) return 128 * (R >> 6) + 8 * (R & 15) + ((R >> 4) & 3); if (AMAP == 2) { const int t = 128 * (R >> 1) - 2 + (R & 1); return t < 0 ? 0 : t; } return R; }
struct StaticOrder {
    int nM, nN, nwg, G, c;
    __device__ void init(int M_, int N_, int G_, int c_) { nM = M_ / BM; nN = N_ / BM; nwg = nM * nN; G = G_; c = c_; }
    __device__ bool next(int i, Unit& u) const {
        const long L = (long)i * G + c; if (L >= nwg) return false;
        int wgid = (int)L; { const int q = nwg / NXCD, r = nwg % NXCD, xcd = wgid % NXCD, off = wgid / NXCD; wgid = (xcd < r ? xcd * (q + 1) : r * (q + 1) + (xcd - r) * q) + off; }
        const int nig = WGM * nN, gid = wgid / nig, fm = gid * WGM, gsz = (nM - fm) < WGM ? (nM - fm) : WGM;
        u.pm = fm + ((wgid % nig) % gsz); u.pn = (wgid % nig) / gsz; return true;
    }
};
template <class Epi>
__device__ __forceinline__ void epi_apply(const f32x4 (&acc)[2][2][4][2], const Unit& u, int wr, int wc, int fr, int fq, const Epi& E) {
#pragma unroll
    for (int ai = 0; ai < 2; ++ai)
#pragma unroll
        for (int m = 0; m < 4; ++m) { const int row = u.pm * BM + ai * HALF + wr * 64 + m * 16 + fr;
#pragma unroll
            for (int bj = 0; bj < 2; ++bj) {
                if constexpr (Epi::PERM) E.st8(row, u.pn * BM + bj * HALF + wc * 32 + 8 * fq, acc[ai][bj][m][0], acc[ai][bj][m][1]);
                else { E(row, u.pn * BM + bj * HALF + wc * 32 + 4 * fq, acc[ai][bj][m][0]); E(row, u.pn * BM + bj * HALF + wc * 32 + 16 + 4 * fq, acc[ai][bj][m][1]); }
            } }
}
template <class Epi, bool ALIGN_EPI, bool SP2, int AMAP>
__device__ __forceinline__ void gemm_phase(LAS unsigned char* lds, const Gemm g, const StaticOrder& S, const Epi& E, int tid_in) {
    static_assert(SP2, "only the SP2 loop is carried here");
    const int tid = tid_in, wid = __builtin_amdgcn_readfirstlane(tid >> 6), lane = tid & 63, wr = wid >> 2, wc = wid & 3, fr = lane & 15, fq = lane >> 4;
    const int K = g.K, nt = K / BK;
    unsigned voffA[2], voffB[2];
#pragma unroll
    for (int i = 0; i < 2; ++i) { int R, C; stage_rc(tid * 16 + i * 8192, R, C); const int Rb = Epi::PERM ? ((R & ~31) + perm32(R & 31)) : R;
        voffA[i] = (unsigned)(amap_row<AMAP>(R) * g.lda + C) * 2u; voffB[i] = (unsigned)(Rb * g.ldb + C) * 2u; }
    const size_t kstep = (size_t)(BK * 2);
    const size_t hA = g.hA, hB = g.hB, tA = g.tA, tB = g.tB;
    const unsigned ldsw = (unsigned)wid * 1024u;
    const int aoff = lds_byte(wr * 64 + fr, fq * 8), boff = lds_byte(wc * 32 + fr, fq * 8);
#define PG8_SA(b, h) (((b) * 2 + (h)) * HTB)
#define PG8_SB(b, h) ((4 + (b) * 2 + (h)) * HTB)
#define PG8_STAGE(bufoff, gbase, voff) do { _Pragma("unroll") for (int _i = 0; _i < 2; ++_i) \
        __builtin_amdgcn_global_load_lds((const unsigned*)((const char*)(gbase) + (voff)[_i]), (LAS unsigned*)(lds + (bufoff) + ldsw + _i * 8192), 16, 0, 0); } while (0)
#define PG8_LDA(dst, b, h) do { _Pragma("unroll") for (int m = 0; m < 4; ++m) _Pragma("unroll") for (int k = 0; k < 2; ++k) dst[m][k] = *(const LAS bf16x8*)(lds + PG8_SA(b, h) + aoff + m * 2048 + k * 1024); } while (0)
#define PG8_LDB(dst, b, h) do { _Pragma("unroll") for (int n = 0; n < 2; ++n) _Pragma("unroll") for (int k = 0; k < 2; ++k) dst[n][k] = *(const LAS bf16x8*)(lds + PG8_SB(b, h) + boff + n * 2048 + k * 1024); } while (0)
#define PG8_MMA(ai, bj, At, Bt) do { __builtin_amdgcn_s_setprio(1); _Pragma("unroll") for (int m = 0; m < 4; ++m) _Pragma("unroll") for (int n = 0; n < 2; ++n) _Pragma("unroll") for (int k = 0; k < 2; ++k) \
        acc[ai][bj][m][n] = __builtin_amdgcn_mfma_f32_16x16x32_bf16(Bt[n][k], At[m][k], acc[ai][bj][m][n], 0, 0, 0); __builtin_amdgcn_s_setprio(0); } while (0)
#define PG8_WAIT_V(n) asm volatile("s_waitcnt vmcnt(" #n ")" ::: "memory")
#define PG8_WAIT_L(n) asm volatile("s_waitcnt lgkmcnt(" #n ")" ::: "memory")
#define PG8_BAR __builtin_amdgcn_s_barrier()
#define PG8_SCHED __builtin_amdgcn_sched_barrier(0)
    Unit cur, nxt; int ui = 0;
    if (!S.next(0, cur)) return;
    f32x4 acc[2][2][4][2];
#pragma unroll
    for (int a = 0; a < 2; ++a)
#pragma unroll
        for (int b = 0; b < 2; ++b)
#pragma unroll
            for (int m = 0; m < 4; ++m)
#pragma unroll
                for (int n = 0; n < 2; ++n) acc[a][b][m][n] = (f32x4){0.f, 0.f, 0.f, 0.f};
    bf16x8 At[4][2], B0[2][2], B1[2][2];
    const char* cA = (const char*)g.A + (size_t)cur.pm * tA; const char* cB = (const char*)g.Bt + (size_t)cur.pn * tB;
    PG8_STAGE(PG8_SB(0, 0), cB, voffB); PG8_STAGE(PG8_SB(0, 1), cB + hB, voffB); PG8_STAGE(PG8_SA(0, 0), cA, voffA); PG8_STAGE(PG8_SA(0, 1), cA + hA, voffA);
    if (wr == 1) PG8_BAR;
    PG8_WAIT_V(2); PG8_BAR;
    PG8_STAGE(PG8_SB(1, 0), cB + kstep, voffB); PG8_STAGE(PG8_SA(1, 0), cA + kstep, voffA); PG8_STAGE(PG8_SB(1, 1), cB + hB + kstep, voffB);
    PG8_WAIT_V(6); PG8_BAR;
#pragma unroll 1
    for (;;) {
        const bool has_next = S.next(ui + 1, nxt);
        const char* nA = has_next ? (const char*)g.A + (size_t)nxt.pm * tA : cA; const char* nB = has_next ? (const char*)g.Bt + (size_t)nxt.pn * tB : cB;
#pragma unroll 1
        for (int t = 0; t < nt; t += 2) {
            const bool last = (t == nt - 2);
            const char* a1 = cA + (size_t)(t + 1) * kstep;
            const char* a2 = last ? nA : cA + (size_t)(t + 2) * kstep; const char* b2 = last ? nB : cB + (size_t)(t + 2) * kstep;
            const char* a3 = a2 + kstep; const char* b3 = b2 + kstep;
            PG8_LDB(B0, 0, 0); PG8_LDB(B1, 0, 1); PG8_SCHED; PG8_LDA(At, 0, 0); PG8_STAGE(PG8_SA(1, 1), a1 + hA, voffA);
            PG8_WAIT_V(8); PG8_WAIT_L(0); PG8_BAR; PG8_MMA(0, 0, At, B0); PG8_MMA(0, 1, At, B1); PG8_BAR; PG8_SCHED;
            PG8_LDA(At, 0, 1); PG8_STAGE(PG8_SB(0, 0), b2, voffB); PG8_STAGE(PG8_SB(0, 1), b2 + hB, voffB); PG8_STAGE(PG8_SA(0, 0), a2, voffA);
            PG8_WAIT_V(8); PG8_WAIT_L(0); PG8_BAR; PG8_MMA(1, 0, At, B0); PG8_MMA(1, 1, At, B1); PG8_BAR; PG8_SCHED;
            PG8_LDB(B0, 1, 0); PG8_LDB(B1, 1, 1); PG8_SCHED; PG8_LDA(At, 1, 0); PG8_STAGE(PG8_SA(0, 1), a2 + hA, voffA);
            PG8_WAIT_V(8); PG8_WAIT_L(0); PG8_BAR; PG8_MMA(0, 0, At, B0); PG8_MMA(0, 1, At, B1); PG8_BAR; PG8_SCHED;
            PG8_LDA(At, 1, 1); PG8_STAGE(PG8_SB(1, 0), b3, voffB); PG8_STAGE(PG8_SB(1, 1), b3 + hB, voffB); PG8_STAGE(PG8_SA(1, 0), a3, voffA);
            PG8_WAIT_V(8); PG8_WAIT_L(0); PG8_BAR; PG8_MMA(1, 0, At, B0); PG8_MMA(1, 1, At, B1); PG8_BAR; PG8_SCHED;
        }
        if constexpr (ALIGN_EPI) { if (wr == 0) PG8_BAR; }
        if constexpr (Epi::WHOLE) E.tile(acc, cur, wr, wc, fr, fq); else epi_apply(acc, cur, wr, wc, fr, fq, E);
        if (!has_next) break;
#pragma unroll
        for (int a = 0; a < 2; ++a)
#pragma unroll
            for (int b = 0; b < 2; ++b)
#pragma unroll
                for (int m = 0; m < 4; ++m)
#pragma unroll
                    for (int n = 0; n < 2; ++n) acc[a][b][m][n] = (f32x4){0.f, 0.f, 0.f, 0.f};
        cur = nxt; cA = nA; cB = nB; ++ui;
        if constexpr (ALIGN_EPI) { if (wr == 1) PG8_BAR; }
    }
    PG8_WAIT_V(0);
    if constexpr (!ALIGN_EPI) { if (wr == 0) PG8_BAR; }
    PG8_BAR;
#undef PG8_SA
#undef PG8_SB
#undef PG8_STAGE
#undef PG8_LDA
#undef PG8_LDB
#undef PG8_MMA
#undef PG8_WAIT_V
#undef PG8_WAIT_L
#undef PG8_BAR
#undef PG8_SCHED
}
}
template <class Epi>
__device__ __forceinline__ void gemm_mfma(const Fr& F, const bf16* A, int lda, const bf16* Bt, int ldb, int Mr, int N, int K, const Epi& E) {
    int tid = F.tid; asm volatile("" : "+v"(tid)); int kk = K; asm volatile("" : "+s"(kk));
    pg8::Gemm g{A, Bt, Mr, N, kk, lda, ldb, (size_t)512 * lda, (size_t)256 * lda, (size_t)512 * ldb, (size_t)256 * ldb}; pg8::StaticOrder S; S.init(Mr, N, F.nb, F.bid);
    pg8::gemm_phase<Epi, true, true, 0>(F.lds, g, S, E, tid);
    __syncthreads();
}
template <class Epi>
__device__ __forceinline__ void gemm_ffn_in(const Fr& F, const bf16* XNp, const bf16* Win  , const Epi& E) {
    int tid = F.tid; asm volatile("" : "+v"(tid)); int kk = D; asm volatile("" : "+s"(kk));
    pg8::Gemm g{XNp, Win, M, 2 * FF, kk, D, D, (size_t)512 * D, (size_t)4 * D * 2, (size_t)128 * D * 2, (size_t)FF * D * 2}; pg8::StaticOrder S; S.init(M, 2 * FF, F.nb, F.bid);
    pg8::gemm_phase<Epi, true, true, 1>(F.lds, g, S, E, tid);
    __syncthreads();
}
template <class Epi>
__device__ __forceinline__ void gemm_ffn_halo(const Fr& F, const bf16* XNp, const bf16* Win, const Epi& E) {
    int tid = F.tid; asm volatile("" : "+v"(tid)); int kk = D; asm volatile("" : "+s"(kk));
    pg8::Gemm g{XNp, Win, 512, FF, kk, D, D, (size_t)16384 * D * 2, (size_t)8192 * D * 2, (size_t)512 * D, (size_t)256 * D}; pg8::StaticOrder S; S.init(512, FF, F.nb, F.bid);
    pg8::gemm_phase<Epi, true, true, 2>(F.lds, g, S, E, tid);
    __syncthreads();
}

__device__ __forceinline__ void load_row_f32(const float* row, int lane, f32x4 (&v)[4]) {
#pragma unroll
    for (int j = 0; j < 4; ++j) v[j] = *(const f32x4*)(row + 4 * lane + 256 * j);
}
__device__ __forceinline__ void load_row_bf16(const bf16* row, int lane, f32x4 (&v)[4]) {
#pragma unroll
    for (int j = 0; j < 4; ++j) { const u32x2 w = *(const u32x2*)(row + 4 * lane + 256 * j); v[j] = (f32x4){bflo(w.x), bfhi(w.x), bflo(w.y), bfhi(w.y)}; }
}
__device__ __forceinline__ void store_row_bf16(bf16* row, int lane, const f32x4 (&v)[4]) {
#pragma unroll
    for (int j = 0; j < 4; ++j) { u32x2 w; w.x = pk2(v[j][0], v[j][1]); w.y = pk2(v[j][2], v[j][3]); *(u32x2*)(row + 4 * lane + 256 * j) = w; }
}
__device__ __forceinline__ float row_ssq(const f32x4 (&v)[4]) {
    float s = 0.f;
#pragma unroll
    for (int j = 0; j < 4; ++j) s += (v[j][0] * v[j][0] + v[j][1] * v[j][1]) + (v[j][2] * v[j][2] + v[j][3] * v[j][3]);
    return wave_sum_dpp(s);
}
__device__ __forceinline__ float row_rinv(const f32x4 (&v)[4]) {
    float s = 0.f;
#pragma unroll
    for (int j = 0; j < 4; ++j) s += (v[j][0] * v[j][0] + v[j][1] * v[j][1]) + (v[j][2] * v[j][2] + v[j][3] * v[j][3]);
    return rsqrtf(wave_sum_dpp(s) * (1.f / D) + NORM_EPS);
}

template <bool XBF> __device__ __forceinline__ void load_row_x(const void* base, size_t row, int lane, f32x4 (&v)[4]) {
    if (XBF) load_row_bf16((const bf16*)base + row * D, lane, v); else load_row_f32((const float*)base + row * D, lane, v); }
template <bool XBF> __device__ __forceinline__ void store_row_x(void* base, size_t row, int lane, const f32x4 (&v)[4]) {
    if (XBF) store_row_bf16((bf16*)base + row * D, lane, v);
    else {
#pragma unroll
        for (int j = 0; j < 4; ++j) *(f32x4*)((float*)base + row * D + 4 * lane + 256 * j) = v[j]; } }
template <bool XBF> __device__ __forceinline__ void ph_a1(const Fr& F, const void* Xs, const float* g0, const float* mu  , int nrows, bf16* hn, bf16* xr, bf16* xk, bf16* xv) {
    const int lane = F.lane;
    f32x4 g[4], m0[4], m1[4], m2[4];
    load_row_f32(g0, lane, g); load_row_f32(mu, lane, m0); load_row_f32(mu + D, lane, m1); load_row_f32(mu + 2 * D, lane, m2);
#pragma unroll 1
    for (int run = F.gw; run < nrows / 4; run += F.ngw) {
        const int t0 = run * 4; const bool first = (t0 % T) == 0;
        f32x4 x[5][4];
        load_row_x<XBF>(Xs, (size_t)(first ? t0 : t0 - 1), lane, x[0]);
#pragma unroll
        for (int i = 0; i < 4; ++i) load_row_x<XBF>(Xs, (size_t)(t0 + i), lane, x[i + 1]);
        float ri[5];
#pragma unroll
        for (int i = 0; i < 5; ++i) ri[i] = row_rinv(x[i]);
        if (first) ri[0] = 0.f;
#pragma unroll
        for (int j = 0; j < 4; ++j) x[0][j] = x[0][j] * ri[0] * g[j];
#pragma unroll
        for (int i = 0; i < 4; ++i) {
            f32x4 o[4];
#pragma unroll
            for (int j = 0; j < 4; ++j) x[i + 1][j] = x[i + 1][j] * ri[i + 1] * g[j];
            const size_t ro = (size_t)(t0 + i) * D;
            store_row_bf16(hn + ro, lane, x[i + 1]);
#pragma unroll
            for (int j = 0; j < 4; ++j) o[j] = x[i + 1][j] + (x[i][j] - x[i + 1][j]) * m0[j];
            store_row_bf16(xr + ro, lane, o);
#pragma unroll
            for (int j = 0; j < 4; ++j) o[j] = x[i + 1][j] + (x[i][j] - x[i + 1][j]) * m1[j];
            store_row_bf16(xk + ro, lane, o);
#pragma unroll
            for (int j = 0; j < 4; ++j) o[j] = x[i + 1][j] + (x[i][j] - x[i + 1][j]) * m2[j];
            store_row_bf16(xv + ro, lane, o);
        }
    }
}
__device__ __forceinline__ void ph_norm(const Fr& F, const bf16* Xs, const float* gv, int tok0, int nrows, bf16* out) {
    f32x4 g[4]; load_row_f32(gv, F.lane, g);
#pragma unroll 1
    for (int lr0 = F.gw * 4; lr0 < nrows; lr0 += F.ngw * 4) {
        f32x4 x[4][4];
#pragma unroll
        for (int i = 0; i < 4; ++i) load_row_bf16(Xs + (size_t)(tok0 + lr0 + i) * D, F.lane, x[i]);
#pragma unroll
        for (int i = 0; i < 4; ++i) { const float ri = row_rinv(x[i]);
#pragma unroll
            for (int j = 0; j < 4; ++j) x[i][j] = x[i][j] * ri * g[j];
            store_row_bf16(out + (size_t)(lr0 + i) * D, F.lane, x[i]); }
    }
}
__device__ __forceinline__ void ph_a3(const Fr& F, const bf16* PQ, int nrows, bf16* ALwa, bf16* ALg) {
    for (size_t idx = (size_t)F.bid * NTHREADS + F.tid; idx < (size_t)nrows * 64; idx += (size_t)F.nb * NTHREADS) {
        const int lr = (int)(idx >> 6), c = (int)(idx & 63) * 8; const bool first = (lr % T) == 0;
        int pc = -1, kind = 0;
        if (c < 64) { pc = c; kind = 0; } else if (c >= 128 && c < 192) { pc = 64 + (c - 128); kind = 1; } else if (c >= 256 && c < 416) { pc = 128 + (c - 256); kind = 2; }
        u32x4 o = (u32x4){0u, 0u, 0u, 0u};
        if (pc >= 0) { const u32x4 pv = *(const u32x4*)(PQ + (size_t)lr * 768 + pc); u32x4 qv = (u32x4){0u, 0u, 0u, 0u}; if (!first) qv = *(const u32x4*)(PQ + (size_t)(lr - 1) * 768 + 288 + pc);
#pragma unroll
            for (int e = 0; e < 4; ++e) { float s0 = bflo(pv[e]) + bflo(qv[e]), s1 = bfhi(pv[e]) + bfhi(qv[e]);
                if (kind == 0) { s0 = 1.f - 2.f * __builtin_amdgcn_rcpf(1.f + __builtin_amdgcn_exp2f(2.885390081777927f * s0)); s1 = 1.f - 2.f * __builtin_amdgcn_rcpf(1.f + __builtin_amdgcn_exp2f(2.885390081777927f * s1)); }
                else if (kind == 2) { s0 = __builtin_amdgcn_rcpf(1.f + __builtin_amdgcn_exp2f(-1.4426950408889634f * s0)); s1 = __builtin_amdgcn_rcpf(1.f + __builtin_amdgcn_exp2f(-1.4426950408889634f * s1)); }
                o[e] = pk2(s0, s1); } }
        if (c < 256) *(u32x4*)(ALwa + (size_t)lr * 256 + c) = o; else *(u32x4*)(ALg + (size_t)lr * 256 + (c - 256)) = o;
    }
}
constexpr int SC_TC = 32, SC_VEC = SC_TC * 64 * 4, SC_BUF = 5 * SC_VEC + SC_TC * 32 * 4;
typedef _Float16 h16x2_t __attribute__((ext_vector_type(2)));
constexpr int S5_BUF = 5 * SC_TC * 64 * 4 + SC_TC * 32 * 4;
__device__ __forceinline__ float red8(float v) { v += dpp_mov<0xB1>(v); v += dpp_mov<0x4E>(v); v += dpp_mov<0x141>(v); return v; }
__device__ __forceinline__ void ph_scan5(const Fr& F, const bf16* Rg, const bf16* Kg, const bf16* Vg, const bf16* Lg, const bf16* Ag, const float* k_k, const float* k_a, const float* r_k, unsigned short* Yg, float* CTg) {
    const GAS bf16* Rb = (const GAS bf16*)Rg; const GAS bf16* Kb = (const GAS bf16*)Kg; const GAS bf16* Vb = (const GAS bf16*)Vg; const GAS bf16* Lb = (const GAS bf16*)Lg; const GAS bf16* Ab = (const GAS bf16*)Ag;
    GAS unsigned short* Y = (GAS unsigned short*)Yg; GAS float* CT = (GAS float*)CTg;
    LAS unsigned char* lds = F.lds; LAS float* Yl = (LAS float*)(lds + 2 * S5_BUF);
    const int lane = F.lane, wave = F.wave, tid = F.tid;
    const bool comp = wave < 4;
    const int rloc = (wave & 3) * 8 + (lane >> 3), kj = (lane & 7) * 8;
    LAS float* yl_base = Yl + rloc * 4 + ((lane & 7) >> 1);
    const int hw = wave & 3, ht = tid & 255;
#pragma unroll 1
    for (int u = F.bid; u < NB * NH * 2; u += F.nb) {
        int hv = u & 1, bh = u >> 1;
        if (F.nb == 256) { const int x = F.bid & 7, y = F.bid >> 3; bh = x * 16 + (y >> 1); hv = y & 1; }
        const int bl = bh / NH, h = bh % NH, c = h * 64 + lane;
        const int half = lane >> 5, cp = lane & 31;
        const f32x2_t kkc2 = *(const f32x2_t*)(k_k + h * 64 + 2 * cp), kac2 = *(const f32x2_t*)(k_a + h * 64 + 2 * cp), rkc2 = *(const f32x2_t*)(r_k + h * 64 + 2 * cp);
        const size_t base = (size_t)(bl * T) * D + c;
        f32x4 Sa = (f32x4){0.f, 0.f, 0.f, 0.f}, Sb = Sa; float py = 0.f;
        unsigned gr[4], gk[4], gv[4], gl[4], ga[4];
#define S5_ISSUE(t0) do { const size_t ub = (size_t)__builtin_amdgcn_readfirstlane((int)(((bl * T) + (t0) + hw * 8) * (D / 64) + h)) * 64;     \
            const GAS unsigned* rp = (const GAS unsigned*)(Rb + ub); const GAS unsigned* kp = (const GAS unsigned*)(Kb + ub); const GAS unsigned* vp = (const GAS unsigned*)(Vb + ub); const GAS unsigned* lp = (const GAS unsigned*)(Lb + ub); const GAS unsigned* ap = (const GAS unsigned*)(Ab + ub); \
            _Pragma("unroll") for (int i = 0; i < 4; ++i) { const int o = (2 * i + half) * (D / 2) + cp; gr[i] = rp[o]; gk[i] = kp[o]; gv[i] = vp[o]; gl[i] = lp[o]; ga[i] = ap[o]; } } while (0)
#define S5_PREP(b, tcur) do { LAS float* Wv = (LAS float*)(lds + (b) * S5_BUF); _Pragma("unroll") for (int i = 0; i < 4; ++i) { const int s = hw * 8 + 2 * i + half; \
            const f32x2_t r2 = {bflo(gr[i]), bfhi(gr[i])}, k2 = {bflo(gk[i]), bfhi(gk[i])}, v2 = {bflo(gv[i]), bfhi(gv[i])}, l2 = {bflo(gl[i]), bfhi(gl[i])}, a2 = {bflo(ga[i]), bfhi(ga[i])}; \
            const f32x2_t kk2 = k2 * kkc2, sq2 = kk2 * kk2; const float hs = half_sum_r13(sq2[0] + sq2[1]); \
            const float sA = __builtin_bit_cast(float, __builtin_amdgcn_readlane(__builtin_bit_cast(int, hs), 31)), sB = __builtin_bit_cast(float, __builtin_amdgcn_readlane(__builtin_bit_cast(int, hs), 63)); \
            const float nrs = -__builtin_amdgcn_rsqf(fmaxf(half ? sB : sA, 1e-24f)); const f32x2_t nkn2 = kk2 * nrs; \
            const f32x2_t kmd2 = k2 * ((a2 - 1.f) * kac2 + 1.f), t2 = r2 * kmd2 * rkc2; const float ctv = half_sum_r13(t2[0] + t2[1]); \
            if (hv == 0 && cp == 31) CT[(size_t)(bl * T + (tcur) + s) * 16 + h] = ctv; \
            f32x2_t dec2; dec2[0] = __builtin_amdgcn_exp2f(l2[0] * 1.4426950408889634f); dec2[1] = __builtin_amdgcn_exp2f(l2[1] * 1.4426950408889634f); \
            *(LAS f32x2_t*)(Wv + s * 64 + 2 * cp) = dec2; *(LAS f32x2_t*)(Wv + SC_TC * 64 + s * 64 + 2 * cp) = nkn2; *(LAS f32x2_t*)(Wv + 2 * SC_TC * 64 + s * 64 + 2 * cp) = nkn2 * (-a2); \
            *(LAS f32x2_t*)(Wv + 3 * SC_TC * 64 + s * 64 + 2 * cp) = kmd2; *(LAS f32x2_t*)(Wv + 4 * SC_TC * 64 + s * 64 + 2 * cp) = r2; \
            if ((cp >> 4) == hv) *(LAS f32x2_t*)(Wv + 5 * SC_TC * 64 + s * 32 + ((2 * cp) & 31)) = v2; } } while (0)
#define S5_YOUT(b, tprev) do { const int s = ht >> 3, rr = (ht & 7) * 4; const LAS f32x4* yp = (const LAS f32x4*)(Yl + (b) * 4096 + s * 128 + rr * 4); const f32x4 y0 = yp[0], y1 = yp[1], y2 = yp[2], y3 = yp[3]; \
            const f32x4 yv = {(y0[0] + y0[1]) + (y0[2] + y0[3]), (y1[0] + y1[1]) + (y1[2] + y1[3]), (y2[0] + y2[1]) + (y2[2] + y2[3]), (y3[0] + y3[1]) + (y3[2] + y3[3])}; \
            const f32x2_t y01 = {yv[0], yv[1]}, y23 = {yv[2], yv[3]}; const h16x2_t h01 = __builtin_convertvector(y01, h16x2_t), h23 = __builtin_convertvector(y23, h16x2_t); \
            u32x2 w; w.x = __builtin_bit_cast(unsigned, h01); w.y = __builtin_bit_cast(unsigned, h23); \
            *(GAS u32x2*)(Y + (size_t)(bl * T + (tprev) + s) * D + h * 64 + hv * 32 + rr) = w; } while (0)
        __syncthreads();
        if (!comp) { S5_ISSUE(0); S5_PREP(0, 0); S5_ISSUE(SC_TC); }
        __syncthreads();
#pragma unroll 1
        for (int t0 = 0; t0 < T; t0 += SC_TC) {
            const int b = (t0 / SC_TC) & 1;
            if (comp) {
                const LAS float* Wv = (const LAS float*)(lds + b * S5_BUF);
#define S5_LOAD(s, w0, w1, a0, a1, b0, b1, k0, k1, r0, r1, v_) do { \
                w0 = *(const LAS f32x4*)(Wv + (s) * 64 + kj); w1 = *(const LAS f32x4*)(Wv + (s) * 64 + kj + 4); a0 = *(const LAS f32x4*)(Wv + SC_TC * 64 + (s) * 64 + kj); a1 = *(const LAS f32x4*)(Wv + SC_TC * 64 + (s) * 64 + kj + 4); \
                b0 = *(const LAS f32x4*)(Wv + 2 * SC_TC * 64 + (s) * 64 + kj); b1 = *(const LAS f32x4*)(Wv + 2 * SC_TC * 64 + (s) * 64 + kj + 4); k0 = *(const LAS f32x4*)(Wv + 3 * SC_TC * 64 + (s) * 64 + kj); k1 = *(const LAS f32x4*)(Wv + 3 * SC_TC * 64 + (s) * 64 + kj + 4); \
                r0 = *(const LAS f32x4*)(Wv + 4 * SC_TC * 64 + (s) * 64 + kj); r1 = *(const LAS f32x4*)(Wv + 4 * SC_TC * 64 + (s) * 64 + kj + 4); v_ = Wv[5 * SC_TC * 64 + (s) * 32 + rloc]; } while (0)
                f32x4 w0, w1, a0, a1, b0, b1, k0, k1, r0, r1; float vv;
                S5_LOAD(0, w0, w1, a0, a1, b0, b1, k0, k1, r0, r1, vv);
#pragma unroll
                for (int s = 0; s < SC_TC; ++s) {
                    f32x4 nw0 = w0, nw1 = w1, na0 = a0, na1 = a1, nb0 = b0, nb1 = b1, nk0 = k0, nk1 = k1, nr0 = r0, nr1 = r1; float nv = vv;
                    if (s + 1 < SC_TC) S5_LOAD(s + 1, nw0, nw1, na0, na1, nb0, nb1, nk0, nk1, nr0, nr1, nv);
                    float sa; { f32x2_t p = __builtin_shufflevector(Sa, Sa, 0, 1) * __builtin_shufflevector(a0, a0, 0, 1);
                        p = __builtin_elementwise_fma(__builtin_shufflevector(Sa, Sa, 2, 3), __builtin_shufflevector(a0, a0, 2, 3), p);
                        p = __builtin_elementwise_fma(__builtin_shufflevector(Sb, Sb, 0, 1), __builtin_shufflevector(a1, a1, 0, 1), p);
                        p = __builtin_elementwise_fma(__builtin_shufflevector(Sb, Sb, 2, 3), __builtin_shufflevector(a1, a1, 2, 3), p); sa = p[0] + p[1]; }
                    f32x4 ta = Sa * w0, tb = Sb * w1;
                    sa += dpp_mov<0xB1>(sa); py += dpp_mov<0xB1>(py);
                    ta = ta + vv * k0; tb = tb + vv * k1;
                    sa += dpp_mov<0x4E>(sa);
                    sa += dpp_mov<0x141>(sa);
                    Sa = ta + sa * b0; Sb = tb + sa * b1;
                    if (s > 0) yl_base[b * 4096 + (s - 1) * 128] = py;
                    { f32x2_t p = __builtin_shufflevector(Sa, Sa, 0, 1) * __builtin_shufflevector(r0, r0, 0, 1);
                        p = __builtin_elementwise_fma(__builtin_shufflevector(Sa, Sa, 2, 3), __builtin_shufflevector(r0, r0, 2, 3), p);
                        p = __builtin_elementwise_fma(__builtin_shufflevector(Sb, Sb, 0, 1), __builtin_shufflevector(r1, r1, 0, 1), p);
                        p = __builtin_elementwise_fma(__builtin_shufflevector(Sb, Sb, 2, 3), __builtin_shufflevector(r1, r1, 2, 3), p); py = p[0] + p[1]; }
                    w0 = nw0; w1 = nw1; a0 = na0; a1 = na1; b0 = nb0; b1 = nb1; k0 = nk0; k1 = nk1; r0 = nr0; r1 = nr1; vv = nv;
                }
#undef S5_LOAD
                { py += dpp_mov<0xB1>(py); yl_base[b * 4096 + 31 * 128] = py; py = 0.f; }
            } else {
                if (t0 > 0) S5_YOUT(b ^ 1, t0 - SC_TC);
                if (t0 + SC_TC < T) {
                    asm volatile("" : "+v"(gr[0]), "+v"(gr[1]), "+v"(gr[2]), "+v"(gr[3]), "+v"(gk[0]), "+v"(gk[1]), "+v"(gk[2]), "+v"(gk[3]), "+v"(gv[0]), "+v"(gv[1]), "+v"(gv[2]), "+v"(gv[3]) :: "memory");
                    asm volatile("" : "+v"(gl[0]), "+v"(gl[1]), "+v"(gl[2]), "+v"(gl[3]), "+v"(ga[0]), "+v"(ga[1]), "+v"(ga[2]), "+v"(ga[3]) :: "memory");
                    S5_PREP(b ^ 1, t0 + SC_TC);
                    if (t0 + 2 * SC_TC < T) S5_ISSUE(t0 + 2 * SC_TC);
                }
            }
            __syncthreads();
        }
        if (!comp) S5_YOUT(1, T - SC_TC);
#undef S5_ISSUE
#undef S5_PREP
#undef S5_YOUT
    }
    __syncthreads();
}
__device__ __forceinline__ void ph_a6(const Fr& F, const unsigned short* Yh, const bf16* Vb, const bf16* Gb, const float* CT, const float* lw, const float* lb, bf16* out, int nrows) {
    const int lane = F.lane, c0 = lane * 16;
    float lwv[16], lbv[16];
#pragma unroll
    for (int e = 0; e < 16; ++e) { lwv[e] = lw[c0 + e]; lbv[e] = lb[c0 + e]; }
#pragma unroll 1
    for (int lr0 = F.gw * 2; lr0 < nrows; lr0 += F.ngw * 2) {
        u32x4 yw[2][2], vw[2][2], gw[2][2]; float cb[2];
#pragma unroll
        for (int i = 0; i < 2; ++i) { const size_t ro = (size_t)(lr0 + i) * D + c0;
            yw[i][0] = *(const u32x4*)(Yh + ro); yw[i][1] = *(const u32x4*)(Yh + ro + 8); vw[i][0] = *(const u32x4*)(Vb + ro); vw[i][1] = *(const u32x4*)(Vb + ro + 8);
            gw[i][0] = *(const u32x4*)(Gb + ro); gw[i][1] = *(const u32x4*)(Gb + ro + 8); cb[i] = CT[(size_t)(lr0 + i) * 16 + (lane >> 2)]; }
#pragma unroll
        for (int i = 0; i < 2; ++i) {
            float y[16], v[16], g[16];
#pragma unroll
            for (int q = 0; q < 2; ++q)
#pragma unroll
                for (int e = 0; e < 4; ++e) { const unsigned uy = yw[i][q][e], uv = vw[i][q][e], ug = gw[i][q][e]; const h16x2_t p = __builtin_bit_cast(h16x2_t, uy);
                    y[8 * q + 2 * e] = (float)p[0]; y[8 * q + 2 * e + 1] = (float)p[1]; v[8 * q + 2 * e] = bflo(uv); v[8 * q + 2 * e + 1] = bfhi(uv); g[8 * q + 2 * e] = bflo(ug); g[8 * q + 2 * e + 1] = bfhi(ug); }
            float s = 0.f;
#pragma unroll
            for (int e = 0; e < 16; ++e) s += y[e];
            s += dpp_mov<0xB1>(s); s += dpp_mov<0x4E>(s);
            const float mean = s * (1.f / 64.f); float q = 0.f;
#pragma unroll
            for (int e = 0; e < 16; ++e) { const float d = y[e] - mean; q += d * d; }
            q += dpp_mov<0xB1>(q); q += dpp_mov<0x4E>(q);
            const float rstd = rsqrtf(q * (1.f / 64.f) + LNX_EPS);
            u32x4 o0, o1; float o[16];
#pragma unroll
            for (int e = 0; e < 16; ++e) o[e] = ((y[e] - mean) * rstd * lwv[e] + lbv[e] + cb[i] * v[e]) * g[e];
#pragma unroll
            for (int e = 0; e < 4; ++e) { o0[e] = pk2(o[2 * e], o[2 * e + 1]); o1[e] = pk2(o[8 + 2 * e], o[8 + 2 * e + 1]); }
            const size_t ro = (size_t)(lr0 + i) * D + c0;
            *(u32x4*)(out + ro) = o0; *(u32x4*)(out + ro + 8) = o1;
        }
    }
}
template <bool SBF, bool DBF> __device__ __forceinline__ void ph_resid(const Fr& F, const void* Xs, void* Xd, const bf16* m, const float* g1v, const float* g2v, int tok0, int nrows, bf16* XN, const float* g3v = nullptr, bf16* XN3 = nullptr, float* rinv_out = nullptr) {
    const int lane = F.lane; f32x4 g1[4], g2[4], g3[4]; load_row_f32(g1v, lane, g1); if (g2v) load_row_f32(g2v, lane, g2); if (g3v) load_row_f32(g3v, lane, g3);
#pragma unroll 1
    for (int lr0 = F.gw * 2; lr0 < nrows; lr0 += F.ngw * 2) {
        f32x4 mv[2][4], x[2][4];
#pragma unroll
        for (int i = 0; i < 2; ++i) { load_row_bf16(m + (size_t)(lr0 + i) * D, lane, mv[i]); load_row_x<SBF>(Xs, (size_t)(tok0 + lr0 + i), lane, x[i]); }
#pragma unroll
        for (int i = 0; i < 2; ++i) {
            const float ri = row_rinv(mv[i]);
#pragma unroll
            for (int j = 0; j < 4; ++j) x[i][j] = x[i][j] + mv[i][j] * ri * g1[j];
            store_row_x<DBF>(Xd, (size_t)(tok0 + lr0 + i), lane, x[i]);
            if (rinv_out && !g2v) { const float q2 = row_ssq(x[i]); if (lane == 0) *(f32x4*)(rinv_out + (size_t)(tok0 + lr0 + i) * 4) = (f32x4){q2, 0.f, 0.f, 0.f}; }
            if (g2v) { const float r2 = row_rinv(x[i]); if (rinv_out && lane == 0) rinv_out[tok0 + lr0 + i] = r2;
#pragma unroll
                for (int j = 0; j < 4; ++j) x[i][j] = x[i][j] * r2;
                if (g3v) { f32x4 y3[4];
#pragma unroll
                    for (int j = 0; j < 4; ++j) y3[j] = x[i][j] * g3[j];
                    store_row_bf16(XN3 + (size_t)(tok0 + lr0 + i) * D, lane, y3); }
#pragma unroll
                for (int j = 0; j < 4; ++j) x[i][j] = x[i][j] * g2[j];
                store_row_bf16(XN + (size_t)(tok0 + lr0 + i) * D, lane, x[i]); }
        }
    }
}
__device__ __forceinline__ void ph_k3(const Fr& F, const float* down  , const float* gv, const float* ct, const float* st, int tok0, bf16* ckv, bf16* KR, int nrows) {
    const int lane = F.lane; const f32x4 g = *(const f32x4*)(gv + 4 * lane);
    for (int lr = F.gw; lr < nrows; lr += F.ngw) {
        const float* row = down + (size_t)lr * 512; const f32x4 x = *(const f32x4*)(row + 4 * lane);
        const float ss = wave_sum_dpp((x[0] * x[0] + x[1] * x[1]) + (x[2] * x[2] + x[3] * x[3])); const float ri = rsqrtf(ss * (1.f / 256.f) + NORM_EPS);
        u32x2 w; w.x = pk2(x[0] * ri * g[0], x[1] * ri * g[1]); w.y = pk2(x[2] * ri * g[2], x[3] * ri * g[3]);
        *(u32x2*)(ckv + (size_t)lr * 256 + 4 * lane) = w;
        if (lane < 16) { const int t = (tok0 + lr) % T; const float x1 = row[256 + lane], x2 = row[272 + lane], cs = ct[t * 16 + lane], sn = st[t * 16 + lane];
            KR[(size_t)(tok0 + lr) * 32 + lane] = (bf16)f2bf(x1 * cs - x2 * sn); KR[(size_t)(tok0 + lr) * 32 + 16 + lane] = (bf16)f2bf(x1 * sn + x2 * cs); }
    }
}
__device__ __forceinline__ void ph_b3(const Fr& F, const float* raw  , const float* gv, bf16* cq, int nrows) {
    const int lane = F.lane;
    for (int lr = F.gw; lr < nrows; lr += F.ngw) {
        float x[6], s = 0.f;
#pragma unroll
        for (int i = 0; i < 6; ++i) { x[i] = raw[(size_t)lr * 512 + lane + 64 * i]; s += x[i] * x[i]; }
        const float ri = rsqrtf(wave_sum_dpp(s) * (1.f / 384.f) + NORM_EPS);
#pragma unroll
        for (int i = 0; i < 6; ++i) cq[(size_t)lr * 384 + lane + 64 * i] = (bf16)f2bf(x[i] * ri * gv[lane + 64 * i]);
    }
}
typedef float f32x16 __attribute__((ext_vector_type(16)));
typedef short s16x8 __attribute__((ext_vector_type(8)));
typedef short s16x4 __attribute__((ext_vector_type(4)));
constexpr int AT_KST = 208, AT_VST = 136, AT_KB = 64 * AT_KST, AT_BUF = AT_KB + 64 * AT_VST;
__device__ __forceinline__ void attn_qk(const LAS unsigned char* kb, const int r, const int hh, const s16x8 (&qf)[6], const float mrun, f32x16& s0, f32x16& s1) {
    s16x8 ka[12];
#pragma unroll
    for (int s = 0; s < 6; ++s) {
        ka[2 * s] = *(const LAS s16x8*)(kb + r * AT_KST + (16 * s + 8 * hh) * 2);
        ka[2 * s + 1] = *(const LAS s16x8*)(kb + (32 + r) * AT_KST + (16 * s + 8 * hh) * 2);
    }
#pragma unroll
    for (int i = 0; i < 16; ++i) { s0[i] = -mrun; s1[i] = -mrun; }
    __builtin_amdgcn_sched_barrier(0);
#pragma unroll
    for (int s = 0; s < 6; ++s) {
        s0 = __builtin_amdgcn_mfma_f32_32x32x16_bf16(ka[2 * s], qf[s], s0, 0, 0, 0);
        s1 = __builtin_amdgcn_mfma_f32_32x32x16_bf16(ka[2 * s + 1], qf[s], s1, 0, 0, 0);
    }
    __builtin_amdgcn_sched_barrier(0);
}
#define AT_MAX4(m, v, b) asm("v_max3_f32 %0, %0, %1, %2\n\tv_max3_f32 %0, %0, %3, %4" : "+v"(m) : "v"(v[b]), "v"(v[b + 1]), "v"(v[b + 2]), "v"(v[b + 3]))
#define AT_MAX8(m, v, b) asm("v_max3_f32 %0, %0, %1, %2\n\tv_max3_f32 %0, %0, %3, %4\n\tv_max3_f32 %0, %0, %5, %6\n\tv_max3_f32 %0, %0, %7, %8" : "+v"(m) : "v"(v[b]), "v"(v[b + 1]), "v"(v[b + 2]), "v"(v[b + 3]), "v"(v[b + 4]), "v"(v[b + 5]), "v"(v[b + 6]), "v"(v[b + 7]))
__device__ __forceinline__ float attn_rowmax(const f32x16& n0, const f32x16& n1) {
    float m = fmaxf(n0[15], n1[15]);
    AT_MAX8(m, n0, 0); AT_MAX8(m, n0, 8); AT_MAX8(m, n1, 0); AT_MAX8(m, n1, 8);
    float xa = m, xb = m; asm("s_nop 1\n\tv_permlane32_swap_b32 %0, %1" : "+v"(xa), "+v"(xb)); return fmaxf(xa, xb);
}
__device__ __forceinline__ void attn_rescale(const float mt, const bool first, f32x16& n0, f32x16& n1, f32x16& o0, f32x16& o1, float& mrun, float& lrun) {
    const bool upd = first || (mt > 8.f);
    if (__any(upd)) {
        const float delta = upd ? mt : 0.f, corr = first ? 1.f : __builtin_amdgcn_exp2f(-delta); mrun += delta; lrun *= corr;
#pragma unroll
        for (int i = 0; i < 16; ++i) { n0[i] -= delta; n1[i] -= delta; o0[i] *= corr; o1[i] *= corr; }
    }
}
#define AT_SB __builtin_amdgcn_sched_barrier(0)
__device__ __forceinline__ void attn_interval(const LAS unsigned char* kbn, const LAS unsigned char* vbc, const int r, const int hh, const s16x8 (&qf)[6], const bool nxt,
                                              f32x16& c0, f32x16& c1, f32x16& n0, f32x16& n1, f32x16& o0, f32x16& o1, float& mrun, float& lrun) {
    constexpr bool NXT = true;
    s16x8 kf[12]; s16x4 vl[8], vh[8]; u32x4 pw[4]; float acca = 0.f, accb = 0.f; float mt = 0.f;
    const LAS unsigned char* kp0 = kbn + r * AT_KST + 16 * hh; const LAS unsigned char* kp1 = kp0 + 32 * AT_KST;
    const LAS unsigned char* vp0 = vbc + r * AT_VST + 8 * hh;  const LAS unsigned char* vp1 = vp0 + 32 * AT_VST;
#define AT_KRD(s_) do { kf[2 * (s_)] = *(const LAS s16x8*)(kp0 + 32 * (s_)); kf[2 * (s_) + 1] = *(const LAS s16x8*)(kp1 + 32 * (s_)); } while (0)
#define AT_VRD(q_) do { const int kc_ = (((q_) >> 1) * 32 + 16 * ((q_) & 1)) * 2; vl[2 * (q_)] = *(const LAS s16x4*)(vp0 + kc_); vh[2 * (q_)] = *(const LAS s16x4*)(vp0 + kc_ + 16); \
                        vl[2 * (q_) + 1] = *(const LAS s16x4*)(vp1 + kc_); vh[2 * (q_) + 1] = *(const LAS s16x4*)(vp1 + kc_ + 16); } while (0)
#define AT_EXP(e_) do { if ((e_) < 16) c0[(e_) & 15] = __builtin_amdgcn_exp2f(c0[(e_) & 15]); else if ((e_) < 32) c1[(e_) & 15] = __builtin_amdgcn_exp2f(c1[(e_) & 15]); } while (0)
#define AT_PACK2(q_, h_) do { _Pragma("unroll") for (int e_ = 2 * (h_); e_ < 2 * (h_) + 2; ++e_) pw[(q_)][e_] = ((q_) >> 1) ? pk2(c1[8 * ((q_) & 1) + 2 * e_], c1[8 * ((q_) & 1) + 2 * e_ + 1]) : pk2(c0[8 * ((q_) & 1) + 2 * e_], c0[8 * ((q_) & 1) + 2 * e_ + 1]); } while (0)
    if (NXT) {
        AT_KRD(0); AT_KRD(1);
#pragma unroll
        for (int i = 0; i < 16; ++i) { n0[i] = -mrun; n1[i] = -mrun; }
    }
    AT_SB;
#pragma unroll
    for (int g = 0; g < 12; ++g) {
        const int s = g >> 1;
        if (g == 0) __builtin_amdgcn_s_setprio(3);
        if (g == 6) __builtin_amdgcn_s_setprio(2);
        if (g & 1) n1 = __builtin_amdgcn_mfma_f32_32x32x16_bf16(kf[2 * s + 1], qf[s], n1, 0, 0, 0);
        else       n0 = __builtin_amdgcn_mfma_f32_32x32x16_bf16(kf[2 * s], qf[s], n0, 0, 0, 0);
        AT_SB;
        if ((g & 1) && s < 4) AT_KRD(s + 2);
        if (g == 8) AT_VRD(0);
        if (g == 10) AT_VRD(1);
        const int e0 = g < 8 ? 3 * g : 24 + 2 * (g - 8), ne = g < 8 ? 3 : 2;
#pragma unroll
        for (int e = e0; e < e0 + ne; ++e) AT_EXP(e);
        if (g == 10) AT_PACK2(0, 0);
        if (g == 11) AT_PACK2(0, 1);
        AT_SB;
    }
#pragma unroll
    for (int g = 0; g < 8; ++g) {
        const int q = g >> 1, h2 = g & 1;
        if (g == 0) __builtin_amdgcn_s_setprio(1);
        if (g == 4) __builtin_amdgcn_s_setprio(0);
        if (h2) { const s16x8 v1 = __builtin_shufflevector(vl[2 * q + 1], vh[2 * q + 1], 0, 1, 2, 3, 4, 5, 6, 7); o1 = __builtin_amdgcn_mfma_f32_32x32x16_bf16(v1, __builtin_bit_cast(s16x8, pw[q]), o1, 0, 0, 0); }
        else    { const s16x8 v0 = __builtin_shufflevector(vl[2 * q], vh[2 * q], 0, 1, 2, 3, 4, 5, 6, 7);         o0 = __builtin_amdgcn_mfma_f32_32x32x16_bf16(v0, __builtin_bit_cast(s16x8, pw[q]), o0, 0, 0, 0); }
        AT_SB;
        if (g == 0) AT_VRD(2);
        if (g == 2) AT_VRD(3);
        if (q < 3) AT_PACK2(q + 1, h2);
#pragma unroll
        for (int i = 4 * h2; i < 4 * h2 + 4; ++i) {
            const float cv = (q >> 1) ? c1[8 * (q & 1) + i] : c0[8 * (q & 1) + i];
            if (i & 1) asm("v_add_f32 %0, %0, %1" : "+v"(accb) : "v"(cv)); else asm("v_add_f32 %0, %0, %1" : "+v"(acca) : "v"(cv));
        }
        if (g == 0) mt = fmaxf(n0[15], n1[15]);
        if (q < 2) AT_MAX4(mt, n0, 8 * q + 4 * h2); else AT_MAX4(mt, n1, 8 * (q - 2) + 4 * h2);
        AT_SB;
    }
    lrun += acca + accb;
    if (nxt) {
        float xa = mt, xb = mt; asm("s_nop 1\n\tv_permlane32_swap_b32 %0, %1" : "+v"(xa), "+v"(xb)); mt = fmaxf(xa, xb);
        attn_rescale(mt, false, n0, n1, o0, o1, mrun, lrun);
    }
#undef AT_KRD
#undef AT_VRD
#undef AT_EXP
#undef AT_PACK2
}
__device__ __forceinline__ void ph_attn_mfma(const Fr& F, const bf16* Qg, const bf16* KNg, const bf16* KRg, const bf16* VTg, int tok0, bf16* Og) {
    const GAS bf16* Q = (const GAS bf16*)Qg; const GAS bf16* KN = (const GAS bf16*)KNg; const GAS bf16* KR = (const GAS bf16*)KRg; const GAS bf16* VT = (const GAS bf16*)VTg; GAS bf16* O = (GAS bf16*)Og;
    LAS unsigned char* lds = F.lds;
    const int tid = F.tid, lane = F.lane, wave = F.wave, r = lane & 31, hh = lane >> 5;
    const int k_key = tid >> 3, k_ch = tid & 7, r_key = tid >> 2, r_ch = tid & 3;
    const unsigned offK = (unsigned)(k_key * D + k_ch * 8) * 2u, offR = (unsigned)(r_key * 32 + r_ch * 8) * 2u, offV = (unsigned)tid * 16u;
#pragma unroll 1
    for (int u = F.bid; u < NB * NH * 8; u += F.nb) {
        int bh = u >> 3, pp = u & 7;
        if (F.nb == 256) { const int x = F.bid & 7, y = F.bid >> 3; bh = (u >> 8) * 32 + x * 4 + (y >> 3); pp = y & 7; }
        const int bl = bh / NH, h = bh % NH;
        const int gtok0 = tok0 + bl * T;
#pragma unroll 1
        for (int hp = 0; hp < 2; ++hp) {
            const int qb = hp ? pp : 15 - pp, ntiles = 4 * qb + 4, mychunk = 4 * qb + (wave >> 1);
            int tq = tid; asm volatile("" : "+v"(tq));
            const int lrow = bl * T + 256 * qb + (tq >> 1 & ~31) + (tq & 31);
            s16x8 qf[6];
#pragma unroll
            for (int s = 0; s < 6; ++s) qf[s] = *(const GAS s16x8*)(Q + (size_t)lrow * 1536 + h * 96 + 16 * s + 8 * (tq >> 5 & 1));
            f32x16 o0, o1;
#pragma unroll
            for (int i = 0; i < 16; ++i) { o0[i] = 0.f; o1[i] = 0.f; }
            float mrun = 0.f, lrun = 0.f;
            u32x4 gk0, gr0, gv0;
#define AT_ISSUE(j, gk, gr, gv) do { const int gt = __builtin_amdgcn_readfirstlane(gtok0 + 64 * (j));        \
                         gk = *(const GAS u32x4*)((const GAS char*)(KN + (size_t)gt * D + h * 64) + offK); \
                         if (tid < 256) gr = *(const GAS u32x4*)((const GAS char*)(KR + (size_t)gt * 32) + offR); \
                         gv = *(const GAS u32x4*)((const GAS char*)(VT + ((size_t)h * (M / 64) + (gt >> 6)) * 4096) + offV); } while (0)
#define AT_WRITE(bo, gk, gr, gv) do { LAS unsigned char* kb = lds + (bo); *(LAS u32x4*)(kb + k_key * AT_KST + k_ch * 16) = gk; \
                         if (tid < 256) *(LAS u32x4*)(kb + r_key * AT_KST + 128 + r_ch * 16) = gr; \
                         LAS unsigned char* vb = kb + AT_KB + k_key * AT_VST + k_ch * 16; *(LAS u32x2*)(vb) = (u32x2){gv.x, gv.y}; *(LAS u32x2*)(vb + 8) = (u32x2){gv.z, gv.w}; } while (0)
            AT_ISSUE(0, gk0, gr0, gv0); AT_WRITE(0, gk0, gr0, gv0); AT_ISSUE(1, gk0, gr0, gv0); __syncthreads();
            f32x16 sa0, sa1, sb0, sb1;
            AT_WRITE(AT_BUF, gk0, gr0, gv0); AT_ISSUE(2, gk0, gr0, gv0);
            attn_qk(lds, r, hh, qf, 0.f, sa0, sa1);
            { const float mt = attn_rowmax(sa0, sa1); attn_rescale(mt, true, sa0, sa1, o0, o1, mrun, lrun); }
            __syncthreads();
            unsigned b0 = 0, b1 = AT_BUF, b2 = 2 * AT_BUF;
#pragma unroll 1
            for (int j = 0; j < ntiles; j += 2) {
                if (j + 2 < ntiles) AT_WRITE(b2, gk0, gr0, gv0);
                if (j + 3 < ntiles) AT_ISSUE(j + 3, gk0, gr0, gv0);
                if (j <= mychunk) attn_interval(lds + b1, lds + b0 + AT_KB, r, hh, qf, j + 1 <= mychunk, sa0, sa1, sb0, sb1, o0, o1, mrun, lrun);
                __syncthreads();
                if (j + 3 < ntiles) AT_WRITE(b0, gk0, gr0, gv0);
                if (j + 4 < ntiles) AT_ISSUE(j + 4, gk0, gr0, gv0);
                if (j + 1 <= mychunk) attn_interval(lds + b2, lds + b1 + AT_KB, r, hh, qf, j + 2 <= mychunk, sb0, sb1, sa0, sa1, o0, o1, mrun, lrun);
                __syncthreads();
                const unsigned t0 = b0; b0 = b2; b2 = b1; b1 = t0;
            }
#undef AT_ISSUE
#undef AT_WRITE
            const float lt = lrun + __shfl_xor(lrun, 32), il = 1.f / lt;
            int to = tid; asm volatile("" : "+v"(to));
            GAS bf16* op = O + (size_t)(bl * T + 256 * qb + (to >> 1 & ~31) + (to & 31)) * D + h * 64 + 4 * (to >> 5 & 1);
#pragma unroll
            for (int g = 0; g < 4; ++g) {
                u32x2 w0, w1; w0.x = pk2(o0[4 * g] * il, o0[4 * g + 1] * il); w0.y = pk2(o0[4 * g + 2] * il, o0[4 * g + 3] * il);
                w1.x = pk2(o1[4 * g] * il, o1[4 * g + 1] * il); w1.y = pk2(o1[4 * g + 2] * il, o1[4 * g + 3] * il);
                *(GAS u32x2*)(op + 8 * g) = w0; *(GAS u32x2*)(op + 32 + 8 * g) = w1;
            }
        }
    }
}

constexpr int NSTEPS = 1 + 2 * (10 + 3) + 3 + 2 * (5 + 3);
#define SB(i) ((bf16*)(ws + SLOT(i)))
#define SF(i) ((float*)(ws + SLOT(i)))
#define P0 ((bf16*)(ws + 100 * MiB))
#define P1 ((bf16*)(ws + 164 * MiB))
#define P2 ((bf16*)(ws + 228 * MiB))
#define P3 ((bf16*)(ws + 292 * MiB))
#define P4 ((bf16*)(ws + 356 * MiB))
#define P5 ((bf16*)(ws + 420 * MiB))
#define PE ((bf16*)(ws + 484 * MiB))
#define PQf ((bf16*)(ws + 252 * MiB))
#define PCT ((float*)(ws + 500 * MiB))
#define SSQ ((float*)(ws + WS_SSQ))
#define SSQX(k) ((float*)(ws + WS_CTL + WS_SSQX))
#define RESID(SF, DF, SQ_, src, dst, gain, use, sq) EpiResid<SF, DF, SQ_>{src, dst, gain, (float*)(ws + WS_RSLOT), (unsigned*)(ws + WS_CTL + WS_RCNT), 32u * (unsigned)(use), sq, F.lds}
#define XSTREAM (L == 3 ? XB2 : XB)
#define XB ((bf16*)X)
#define XB2 ((bf16*)(ws + 382 * MiB))
#define kvn SB(0)
#define down SF(1)
#define ckv SB(2)
#define hn SB(0)
#define cqr SF(1)
#define cq SB(2)
#define Qb SB(3)
#define Ob SB(5)
#define mbB SB(0)
#define Hfull SB(0)
#define Ghalo SF(6)
__global__ void __launch_bounds__(NTHREADS, 2) mk_fwd(P p) {
    extern __shared__ __attribute__((aligned(16))) unsigned char lds_raw[];
    Fr F0; F0.lds = (LAS unsigned char*)lds_raw; F0.tid = threadIdx.x; F0.lane = F0.tid & 63; F0.wave = __builtin_amdgcn_readfirstlane(F0.tid >> 6);
    F0.bid = blockIdx.x; F0.nb = gridDim.x; F0.gw = F0.bid * NWAVES + F0.wave; F0.ngw = F0.nb * NWAVES;
    const Fr& F = F0;
    volatile LAS unsigned* misc = (volatile LAS unsigned*)(F.lds + LDS_BYTES - 64);
    if (F.tid < 16) misc[F.tid] = 0u;
    __syncthreads();
    unsigned char* ws0 = p.ws;
    LAS unsigned long long* ptab = (LAS unsigned long long*)(F0.lds + LDS_BYTES - 512);
    if (F0.tid < 30) ptab[F0.tid] = (unsigned long long)p.in[F0.tid];
    if (F0.tid == 30) ptab[30] = (unsigned long long)p.X;
    __syncthreads();
    XcdBarrier bar; bar.bar = (unsigned*)(ws0 + WS_CTL) + 4096; bar.x = 0; bar.st = misc;
    if (p.s_hi - p.s_lo > 1) bar = xcd_barrier_post((unsigned*)(ws0 + WS_CTL) + 4096, misc);
    int step = 0;
#define IN(k) ((const float*)(const GAS float*)ldptr(ptab, (k)))
#define RUN(body) do { if (p.s_lo <= step && step < p.s_hi) { { Fr F = F0; asm volatile("" : "+v"(F.tid)); F.lane = F.tid & 63; F.wave = __builtin_amdgcn_readfirstlane(F.tid >> 6); asm volatile("" : "+s"(F.bid)); F.gw = F.bid * NWAVES + F.wave; GAS unsigned char* ws = (GAS unsigned char*)ws0; asm volatile("" : "+s"(ws)); const float* ct = (const float*)(ws + WS_COS); const float* st = (const float*)(ws + WS_SIN); bf16* XN = (bf16*)(ws + A_XN); bf16* KN = (bf16*)(ws + A_KN); bf16* VT = (bf16*)(ws + A_VT); bf16* KR = (bf16*)(ws + A_KR); float* X = (float*)(GAS float*)ldptr(ptab, 30); const float* ng = IN(1) + (size_t)L * 4 * D; const float* Xs = (L == 0) ? IN(0) : (const float*)X; (void)ct; (void)st; (void)XN; (void)KN; (void)VT; (void)KR; (void)ng; (void)Xs; body; } if (step + 1 < p.s_hi) xcd_barrier(bar); } ++step; } while (0)


    { const int L = 0; RUN(prologue(F, ptab, (unsigned char*)ws)); }

    for (int L = 0; L < 4; ++L) {
        if (L < 2) {
            const int i = L;
            RUN({ if (L == 0) ph_a1<false>(F, IN(0), ng, IN(6) + (size_t)i * 6 * D, M, P0, P4, P5, P3); else ph_a1<true>(F, XB, ng, IN(6) + (size_t)i * 6 * D, M, P0, P4, P5, P3); });
            RUN({ gemm_mfma(F, P0, D, (bf16*)(ws + W_LD) + (size_t)i * 768 * D, D, M, 768, D, EpiBf16{P1, 768, 768});
                  gemm_mfma(F, P4, D, (bf16*)(ws + W_RKV) + (size_t)(i * 3 + 0) * D * D, D, M, D, D, EpiBf16{P2, D, D}); });
            RUN({ ph_a3(F, P1, M, P0, PE);
                  gemm_mfma(F, P5, D, (bf16*)(ws + W_RKV) + (size_t)(i * 3 + 1) * D * D, D, M, D, D, EpiBf16{P4, D, D}); });
            RUN({ gemm_mfma(F, P0, 256, (bf16*)(ws + W_W2) + (size_t)i * D * 128, 128, M, D, 128, EpiDecay{P1, IN(8) + (size_t)i * D});
                  gemm_mfma(F, P0 + 128, 256, (bf16*)(ws + W_A2) + (size_t)i * D * 128, 128, M, D, 128, EpiSigB{P5, IN(11) + (size_t)i * D}); });
            RUN(gemm_mfma(F, P3, D, (bf16*)(ws + W_RKV) + (size_t)(i * 3 + 2) * D * D, D, M, D, D, EpiBf16{P0, D, D}));
            RUN(ph_scan5(F, P2, P4, P0, P1, P5, IN(16) + (size_t)i * D, IN(17) + (size_t)i * D, IN(18) + (size_t)i * D, (unsigned short*)P3, PCT));
            RUN(gemm_mfma(F, PE, 256, (bf16*)(ws + W_G2) + (size_t)i * D * 256, 256, M, D, 256, EpiBf16{P1, D, D}));
            RUN(ph_a6(F, (const unsigned short*)P3, P0, P1, PCT, IN(19) + (size_t)i * D, IN(20) + (size_t)i * D, P3, M));
            RUN(gemm_mfma(F, P3, D, (bf16*)(ws + W_OA) + (size_t)i * D * D, D, M, D, D, EpiBf16{P2, D, D}));
            RUN({ if (L == 0) (ph_resid<false, true>)(F, IN(0), XB, P2, ng + D, nullptr, 0, M, nullptr, nullptr, nullptr, SSQX(L)); else (ph_resid<true, true>)(F, XB, XB, P2, ng + D, nullptr, 0, M, nullptr, nullptr, nullptr, SSQX(L)); });
        } else {
            const int j = L - 2;
            if (L == 2) {
                RUN(gemm_mfma(F, XB, D, (bf16*)(ws + W_KVD), D, M, 512, D, EpiF32RS{(float*)P1, 512, SSQX(4)}));
                RUN(ph_k3(F, (const float*)P1, IN(24), ct, st, 0, P2, KR, M));
                RUN({ gemm_mfma(F, P2, 256, (bf16*)(ws + W_KVUK), 256, M, D, 256, EpiBf16{KN, D, D});
                      gemm_mfma(F, (bf16*)(ws + W_KVUV), 256, P2, 256, D, M, 256, EpiVT{VT}); });
            }
            RUN(gemm_mfma(F, XB, D, (bf16*)(ws + W_QD) + (size_t)j * 512 * D, D, M, 512, D, EpiCqRaw{P1, SSQX(4 + j), SSQ + (size_t)j * M, 384}));
            RUN(gemm_mfma(F, P1, 512, (bf16*)(ws + W_QU) + (size_t)j * 1536 * 384, 384, M, 1536, 384, EpiQRope{PQf, ct, st, 0, SSQ + (size_t)j * M}));
            RUN(ph_attn_mfma(F, PQf, KN, KR, VT, 0, P0));
            RUN(gemm_mfma(F, P0, D, (bf16*)(ws + W_OM) + (size_t)j * D * D, D, M, D, D, EpiBf16{P1, D, D}));
            RUN({ if (L == 3) (ph_resid<true, true>)(F, XB, XB2, P1, ng + D, nullptr, 0, M, nullptr, nullptr, nullptr, SSQX(L)); else (ph_resid<true, true>)(F, XB, XB, P1, ng + D, nullptr, 0, M, nullptr, nullptr, nullptr, SSQX(L)); });
        }
        RUN(gemm_ffn_halo(F, XSTREAM, (bf16*)(ws + W_FIN) + (size_t)L * 2 * FF * D, EpiF32{Ghalo, FF, FF}));
        RUN(gemm_ffn_in(F, XSTREAM, (bf16*)(ws + W_FIN) + (size_t)L * 2 * FF * D, EpiFfn{Hfull, IN(3) + (size_t)L * 3 * FF, IN(4) + (size_t)L * FF, Ghalo, SSQX(L)}));
        RUN({ if (L == 0) gemm_mfma(F, Hfull, FF, (bf16*)(ws + W_FOUT) + (size_t)L * D * FF, FF, M, D, FF, RESID(false, false, false, (const void*)XB, (void*)XB, ng + 3 * D, 1, (float*)nullptr));
              else if (L == 1) gemm_mfma(F, Hfull, FF, (bf16*)(ws + W_FOUT) + (size_t)L * D * FF, FF, M, D, FF, RESID(false, false, true, (const void*)XB, (void*)XB, ng + 3 * D, 2, SSQX(4)));
              else if (L == 2) gemm_mfma(F, Hfull, FF, (bf16*)(ws + W_FOUT) + (size_t)L * D * FF, FF, M, D, FF, RESID(false, false, true, (const void*)XB, (void*)XB, ng + 3 * D, 3, SSQX(5)));
              else gemm_mfma(F, Hfull, FF, (bf16*)(ws + W_FOUT) + (size_t)L * D * FF, FF, M, D, FF, RESID(false, true, false, (const void*)XB2, (void*)X, ng + 3 * D, 4, (float*)nullptr)); });
    }
#undef RUN
}

extern "C" void kernel_launch(void* const* d_in, const int* in_sizes, int n_in, void* d_out, int out_size, void* d_ws, size_t ws_size, hipStream_t stream) {
    static int grid = 0;
    if (grid == 0) {
        if (n_in != 30 || out_size != M * D || ws_size < WS_NEED) { fprintf(stderr, "kernel_launch: unexpected shapes n_in %d out %d ws %zu\n", n_in, out_size, ws_size); grid = -1; return; }
        int dev = 0, cus = 0;
        if (hipGetDevice(&dev) != hipSuccess || hipDeviceGetAttribute(&cus, hipDeviceAttributeMultiprocessorCount, dev) != hipSuccess) { grid = -1; return; }
        if (hipFuncSetAttribute((const void*)mk_fwd, hipFuncAttributeMaxDynamicSharedMemorySize, LDS_BYTES) != hipSuccess) { fprintf(stderr, "kernel_launch: hipFuncSetAttribute failed\n"); grid = -1; return; }
        int per_cu = 0;
        (void)hipOccupancyMaxActiveBlocksPerMultiprocessor(&per_cu, (const void*)mk_fwd, NTHREADS, LDS_BYTES);
        (void)hipGetLastError();
        grid = cus;
    }
    if (grid < 0) return;
    (void)hipMemsetAsync((char*)d_ws + WS_CTL, 0, CTL_BYTES, stream);
    P p{};
    for (int i = 0; i < 30; ++i) p.in[i] = (const float*)d_in[i];
    p.X = (float*)d_out; p.ws = (unsigned char*)d_ws;
#if ONE_LAUNCH
    p.s_lo = 0; p.s_hi = NSTEPS;
    hipLaunchKernelGGL(mk_fwd, dim3(grid), dim3(NTHREADS), LDS_BYTES, stream, p);
#else
    for (int s = 0; s < NSTEPS; ++s) { p.s_lo = s; p.s_hi = s + 1; hipLaunchKernelGGL(mk_fwd, dim3(grid), dim3(NTHREADS), LDS_BYTES, stream, p); }
#endif
}
```

```cpp
#include <hip/hip_runtime.h>
#include <cstdio>
#include <cstdint>

#define LAS __attribute__((address_space(3)))
#define GAS __attribute__((address_space(1)))
typedef unsigned short bf16;
typedef float f32x4 __attribute__((ext_vector_type(4)));
typedef unsigned u32x4 __attribute__((ext_vector_type(4)));
typedef unsigned u32x2 __attribute__((ext_vector_type(2)));

#ifndef ONE_LAUNCH
#define ONE_LAUNCH 1
#endif

constexpr int NB = 8, T = 4096, D = 1024, M = NB * T, MH = M / 2, MQ = M / 4, FF = 2816, NH = 16;
constexpr int NTHREADS = 512, NWAVES = 8;
constexpr int LDS_BYTES = 147456;
constexpr float NORM_EPS = 1e-6f, LNX_EPS = 64e-5f;
__device__ __forceinline__ float rs_inv4(const float* part, size_t row) { const f32x4 q = *(const GAS f32x4*)((const GAS float*)part + row * 4); return rsqrtf(((q[0] + q[1]) + (q[2] + q[3])) * (1.f / 1024.f) + NORM_EPS); }

constexpr size_t MiB = 1u << 20;
constexpr size_t WS_CTL = 0, CTL_BYTES = 1 * MiB;
constexpr size_t WS_SSQ = 99 * MiB + 640 * 1024;
constexpr size_t WS_COS = 1 * MiB, WS_SIN = WS_COS + 256 * 1024;
constexpr size_t WS_W = 2 * MiB;
constexpr size_t W_RKV = WS_W;
constexpr size_t W_OA = W_RKV + 12 * MiB;
constexpr size_t W_LD = W_OA + 4 * MiB;
constexpr size_t W_W2 = W_LD + 3 * MiB;
constexpr size_t W_A2 = W_W2 + 512 * 1024;
constexpr size_t W_G2 = W_A2 + 512 * 1024;
constexpr size_t W_FIN = W_G2 + 1 * MiB;
constexpr size_t W_FOUT = W_FIN + 44 * MiB;
constexpr size_t W_KVD = W_FOUT + 22 * MiB;
constexpr size_t W_KVUK = W_KVD + 1 * MiB;
constexpr size_t W_KVUV = W_KVUK + 512 * 1024;
constexpr size_t W_QD = W_KVUV + 512 * 1024;
constexpr size_t W_QU = W_QD + 2 * MiB;
constexpr size_t W_OM = W_QU + 2 * MiB + 256 * 1024;
constexpr size_t W_END = W_OM + 4 * MiB;
static_assert(W_END <= 100 * MiB, "weights");
constexpr size_t A_XN = 100 * MiB;
constexpr size_t A_S0 = 164 * MiB;
#define SLOT(i) (A_S0 + (size_t)(i) * 32 * MiB)
constexpr size_t A_KN = 382 * MiB, A_VT = 446 * MiB, A_KR = 510 * MiB, WS_NEED = 512 * MiB;

struct P { const float* in[30]; float* X; unsigned char* ws; int s_lo, s_hi; };

__device__ __forceinline__ unsigned f2bf(float f) { unsigned u = __builtin_bit_cast(unsigned, f); return (u + 0x7fffu + ((u >> 16) & 1u)) >> 16; }
typedef float f32x2_t __attribute__((ext_vector_type(2)));
typedef __bf16 b16x2_t __attribute__((ext_vector_type(2)));
typedef _Float16 h16x2_t __attribute__((ext_vector_type(2)));
__device__ __forceinline__ unsigned pk2(float lo, float hi) { const f32x2_t v = {lo, hi}; return __builtin_bit_cast(unsigned, __builtin_convertvector(v, b16x2_t)); }
template <int CTRL> __device__ __forceinline__ float dpp_mov0(float v) { const int iv = __builtin_bit_cast(int, v); return __builtin_bit_cast(float, __builtin_amdgcn_update_dpp(0, iv, CTRL, 0xf, 0xf, true)); }
__device__ __forceinline__ float bf2f(unsigned short b) { return __builtin_bit_cast(float, (unsigned)b << 16); }
__device__ __forceinline__ float bflo(unsigned w) { return __builtin_bit_cast(float, w << 16); }
__device__ __forceinline__ float bfhi(unsigned w) { return __builtin_bit_cast(float, w & 0xffff0000u); }
__device__ __forceinline__ float wave_sum(float v) {
#pragma unroll
    for (int o = 1; o < 64; o <<= 1) v += __shfl_xor(v, o);
    return v;
}
template <int CTRL> __device__ __forceinline__ float dpp_mov(float v) { return __builtin_bit_cast(float, __builtin_amdgcn_update_dpp(0, __builtin_bit_cast(int, v), CTRL, 0xf, 0xf, false)); }
__device__ __forceinline__ float red16(float v) { v += dpp_mov<0xB1>(v); v += dpp_mov<0x4E>(v); v += dpp_mov<0x141>(v); v += dpp_mov<0x140>(v); return v; }
__device__ __forceinline__ float wave_sum_dpp(float v) { v = red16(v);
    v += __builtin_bit_cast(float, __builtin_amdgcn_update_dpp(0, __builtin_bit_cast(int, v), 0x142, 0xa, 0xf, false));
    v += __builtin_bit_cast(float, __builtin_amdgcn_update_dpp(0, __builtin_bit_cast(int, v), 0x143, 0xc, 0xf, false));
    return __builtin_bit_cast(float, __builtin_amdgcn_readlane(__builtin_bit_cast(int, v), 63)); }
__device__ __forceinline__ float half_sum_r13(float v) { v = red16(v);
    asm volatile("s_nop 1\n\tv_add_f32_dpp %0, %0, %0 row_bcast:15 row_mask:0xa" : "+v"(v));
    return v; }
__device__ __forceinline__ float wave_sum_l63(float v) { v = red16(v);
    asm volatile("s_nop 1\n\tv_add_f32_dpp %0, %0, %0 row_bcast:15 row_mask:0xa\n\ts_nop 1\n\tv_add_f32_dpp %0, %0, %0 row_bcast:31 row_mask:0xc" : "+v"(v));
    return v; }
__device__ __forceinline__ float sigmoidf_(float x) { return 1.f / (1.f + __expf(-x)); }
__device__ __forceinline__ float gelu_tanh(float x) { const float u = 0.7978845608028654f * (x + 0.044715f * x * x * x); return 0.5f * x * (1.f + tanhf(u)); }

#define XB_TMO      128
#define XB_XCNT(j)  (256  + 64 * (j))
#define XB_XSUB(j)  (1280 + 64 * (j))
#define XB_XGEN(j)  (2304 + 64 * (j))
#define XB_TOP      3328
#define XB_TOPGEN   3392
#define XCD_BAR_WORDS 3456
#define XB_SPIN_CAP (1u << 22)
__device__ __forceinline__ unsigned xb_ld(unsigned* p)              { return __hip_atomic_load(p, __ATOMIC_RELAXED, __HIP_MEMORY_SCOPE_AGENT); }
__device__ __forceinline__ unsigned xb_add(unsigned* p, unsigned v) { return __hip_atomic_fetch_add(p, v, __ATOMIC_RELAXED, __HIP_MEMORY_SCOPE_AGENT); }
__device__ __forceinline__ unsigned xb_xcc_id() { return (unsigned)__builtin_amdgcn_s_getreg((3 << 11) | 20) & 0xFu; }
#define XB_SPIN(cond, bar) do { unsigned _sp = 0; while (cond) { __builtin_amdgcn_s_sleep(1); \
    if ((++_sp & 255u) == 0u) { if (xb_ld(&(bar)[XB_TMO])) break; if (_sp > XB_SPIN_CAP) { atomicAdd(&(bar)[XB_TMO], 1u); break; } } } } while (0)
struct XcdBarrier { unsigned* bar; unsigned x; volatile LAS unsigned* st; };
__device__ __forceinline__ XcdBarrier xcd_barrier_post(unsigned* bar, volatile LAS unsigned* st) {
    XcdBarrier b; b.bar = bar; b.x = xb_xcc_id(); b.st = st;
    if (threadIdx.x == 0) (void)xb_add(&bar[XB_XCNT(b.x)], 1u);
    return b;
}
__device__ __forceinline__ void xcd_barrier_complete(unsigned* bar, unsigned x, unsigned& nloc, unsigned& nx) {
    const unsigned G = gridDim.x * gridDim.y * gridDim.z;
    unsigned sum, cnt, mine, sp = 0u;
    for (;;) {
        sum = 0u; cnt = 0u; mine = 0u;
#pragma unroll
        for (unsigned j = 0; j < 16; ++j) { const unsigned c = xb_ld(&bar[XB_XCNT(j)]); sum += c; cnt += (c > 0u) ? 1u : 0u; mine = (j == x) ? c : mine; }
        if (sum == G) break;
        __builtin_amdgcn_s_sleep(1);
        if ((++sp & 255u) == 0u) { if (xb_ld(&bar[XB_TMO])) break; if (sp > XB_SPIN_CAP) { atomicAdd(&bar[XB_TMO], 1u); break; } }
    }
    nloc = mine > 0u ? mine : 1u; nx = cnt > 0u ? cnt : 1u;
}
__device__ __forceinline__ void xcd_barrier(const XcdBarrier& b) {
    asm volatile("s_waitcnt vmcnt(0)" ::: "memory");
    __syncthreads();
    if (threadIdx.x == 0) {
        unsigned* bar = b.bar;
        __builtin_amdgcn_s_waitcnt(0);
        unsigned nloc = b.st[0], nx = b.st[1];
        if (nloc == 0u) { xcd_barrier_complete(bar, b.x, nloc, nx); b.st[0] = nloc; b.st[1] = nx; }
        const unsigned old = xb_add(&bar[XB_XSUB(b.x)], 1u);
        const unsigned gen = old / nloc;
        if (old + 1u == (gen + 1u) * nloc) {
            __builtin_amdgcn_fence(__ATOMIC_RELEASE, "agent");
            asm volatile("s_waitcnt vmcnt(0)" ::: "memory");
            const unsigned og = xb_add(&bar[XB_TOP], 1u);
            const unsigned tg = og / nx;
            if (og + 1u == (tg + 1u) * nx) xb_add(&bar[XB_TOPGEN], 1u);
            else XB_SPIN(xb_ld(&bar[XB_TOPGEN]) == tg, bar);
            __builtin_amdgcn_fence(__ATOMIC_ACQUIRE, "agent");
            xb_add(&bar[XB_XGEN(b.x)], 1u);
            asm volatile("s_waitcnt vmcnt(0)" ::: "memory");
        } else {
            XB_SPIN(xb_ld(&bar[XB_XGEN(b.x)]) == gen, bar);
            __builtin_amdgcn_fence(__ATOMIC_ACQUIRE, "agent");
            asm volatile("s_waitcnt vmcnt(0)" ::: "memory");
        }
    }
    __syncthreads();
}

struct Fr { LAS unsigned char* lds; int tid, lane, wave, bid, nb, gw, ngw; };

struct TJob { const float* src; int K, ld, ngroups, gw, gstride, goff; bf16* dst; int ldd, Kpad; const float* sc; int scmode; const float* sc2; };
struct TJobL { unsigned long long src, dst, sc, sc2; int K, ld, ngroups, gw, gstride, goff, ldd, Kpad, scmode, first, pad0, pad1; };
static_assert(sizeof(TJobL) == 80, "TJobL");
constexpr int TJ_TAB = 73728, TJ_CNT = TJ_TAB + 64 * 80;
__device__ __forceinline__ void tjob_run(const Fr& F, const TJob& J) {
    if (F.tid == 0) {
        LAS TJobL* jt = (LAS TJobL*)(F.lds + TJ_TAB); LAS int* cnt = (LAS int*)(F.lds + TJ_CNT);
        const int n = cnt[0], first = cnt[1], items = (J.Kpad / 64) * (J.ngroups * J.gw / 32);
        TJobL L; L.src = (unsigned long long)J.src; L.dst = (unsigned long long)J.dst; L.sc = (unsigned long long)J.sc; L.sc2 = (unsigned long long)J.sc2; L.pad0 = 0; L.pad1 = 0; L.K = J.K; L.ld = J.ld; L.ngroups = J.ngroups; L.gw = J.gw; L.gstride = J.gstride; L.goff = J.goff;
        L.ldd = J.ldd; L.Kpad = J.Kpad; L.scmode = J.scmode; L.first = first; { LAS int* dp = (LAS int*)(jt + n); const int* sp = (const int*)&L;
#pragma unroll
            for (int q = 0; q < 20; ++q) dp[q] = sp[q]; } cnt[0] = n + 1; cnt[1] = first + items;
    }
}
__device__ __forceinline__ void tjob_exec(const Fr& F, const int item_lo, const int item_hi) {
    __syncthreads();
    LAS TJobL* jt = (LAS TJobL*)(F.lds + TJ_TAB); LAS int* cnt = (LAS int*)(F.lds + TJ_CNT);
    const int nj = cnt[0], total = item_hi, lane = F.lane;
    LAS float* scr = (LAS float*)(F.lds + F.wave * 8448);
#pragma unroll 1
    for (int git = item_lo + F.gw; git < total; git += F.ngw) {
        int ji = 0;
        for (int q = 1; q < nj; ++q) if (jt[q].first <= git) ji = q;
        ji = __builtin_amdgcn_readfirstlane(ji);
        TJobL J; { const LAS int* sp = (const LAS int*)(jt + ji); int* dp = (int*)&J;
#pragma unroll
            for (int q = 0; q < 20; ++q) dp[q] = __builtin_amdgcn_readfirstlane(sp[q]); }
        const float* Jsrc = (const float*)(const GAS float*)J.src; const float* Jsc = (const float*)(const GAS float*)J.sc; const float* Jsc2 = (const float*)(const GAS float*)J.sc2; bf16* Jdst = (bf16*)(GAS bf16*)J.dst;
        const int it = git - J.first;
        const int Ntot = J.ngroups * J.gw, nblk = Ntot / 32;
        const int kb = it / nblk, nbk = it % nblk, k0 = 64 * kb, n0 = 32 * nbk;
        const int grp = n0 / J.gw, within = n0 % J.gw, col0 = grp * J.gstride + J.goff + within;
#pragma unroll 8
        for (int i = 0; i < 32; ++i) {
            const int kk = 2 * i + (lane >> 5), k = k0 + kk; float v = 0.f;
            if (k < J.K) { v = Jsrc[(size_t)k * J.ld + col0 + (lane & 31)]; if (J.sc) { const float s = Jsc[k]; v *= J.scmode ? s : (1.f - s); } if (J.sc2) v *= Jsc2[k]; }
            scr[kk * 33 + (lane & 31)] = v;
        }
        asm volatile("s_waitcnt lgkmcnt(0)" ::: "memory");
        const int c = lane & 7;
#pragma unroll
        for (int j = 0; j < 4; ++j) { const int n = (lane >> 3) + 8 * j; const LAS float* s = scr + (8 * c) * 33 + n;
            u32x4 o; o.x = pk2(s[0 * 33], s[1 * 33]); o.y = pk2(s[2 * 33], s[3 * 33]); o.z = pk2(s[4 * 33], s[5 * 33]); o.w = pk2(s[6 * 33], s[7 * 33]);
            *(u32x4*)(Jdst + (size_t)(n0 + n) * J.ldd + k0 + 8 * c) = o; }
        asm volatile("s_waitcnt lgkmcnt(0)" ::: "memory");
    }
}
__device__ __forceinline__ TJob mkjob(const float* src, int K, int ld, int N, bf16* dst, int ldd, int Kpad) { TJob j; j.src = src; j.K = K; j.ld = ld; j.ngroups = 1; j.gw = N; j.gstride = 0; j.goff = 0; j.dst = dst; j.ldd = ldd; j.Kpad = Kpad; j.sc = nullptr; j.scmode = 0; j.sc2 = nullptr; return j; }
__device__ __forceinline__ void zero_rows(const Fr& F, bf16* dst, size_t nelem) {
    for (size_t i = ((size_t)F.bid * NTHREADS + F.tid) * 8; i < nelem; i += (size_t)F.nb * NTHREADS * 8) *(u32x4*)(dst + i) = (u32x4){0u, 0u, 0u, 0u};
}
__device__ __forceinline__ unsigned long long ldptr(LAS unsigned long long* t, int k) { const unsigned long long v = t[k]; return ((unsigned long long)(unsigned)__builtin_amdgcn_readfirstlane((int)(unsigned)(v >> 32)) << 32) | (unsigned long long)(unsigned)__builtin_amdgcn_readfirstlane((int)(unsigned)v); }
constexpr size_t WS_TJ = 960 * 1024;
constexpr int HALO_WGS = 22;
__device__ __forceinline__ void prologue_rwkv_jobs(const Fr& F, LAS unsigned long long* ptab, unsigned char* ws, const int i) {
        for (int n = 0; n < 3; ++n) tjob_run(F, mkjob(((const float*)ldptr(ptab, 7)) + (size_t)(i * 3 + n) * D * D, D, D, D, (bf16*)(ws + W_RKV) + (size_t)(i * 3 + n) * D * D, D, D));
        tjob_run(F, mkjob(((const float*)ldptr(ptab, 21)) + (size_t)i * D * D, D, D, D, (bf16*)(ws + W_OA) + (size_t)i * D * D, D, D));
        bf16* ld = (bf16*)(ws + W_LD) + (size_t)i * 768 * D;
        for (int pq = 0; pq < 2; ++pq) {
            TJob j;
            const float* g0f = (i == 1) ? ((const float*)ldptr(ptab, 1)) + (size_t)(i * 4) * D : nullptr;
            j = mkjob(((const float*)ldptr(ptab, 9)) + (size_t)i * D * 64, D, 64, 64, ld + (size_t)(pq * 288 + 0) * D, D, D);    j.sc = ((const float*)ldptr(ptab, 6)) + (size_t)(i * 6 + 3) * D; j.scmode = pq; j.sc2 = g0f; tjob_run(F, j);
            j = mkjob(((const float*)ldptr(ptab, 12)) + (size_t)i * D * 64, D, 64, 64, ld + (size_t)(pq * 288 + 64) * D, D, D);  j.sc = ((const float*)ldptr(ptab, 6)) + (size_t)(i * 6 + 4) * D; j.scmode = pq; j.sc2 = g0f; tjob_run(F, j);
            j = mkjob(((const float*)ldptr(ptab, 14)) + (size_t)i * D * 160, D, 160, 160, ld + (size_t)(pq * 288 + 128) * D, D, D); j.sc = ((const float*)ldptr(ptab, 6)) + (size_t)(i * 6 + 5) * D; j.scmode = pq; j.sc2 = g0f; tjob_run(F, j);
        }
        zero_rows(F, ld + (size_t)576 * D, (size_t)192 * D);
        tjob_run(F, mkjob(((const float*)ldptr(ptab, 10)) + (size_t)i * 64 * D, 64, D, D, (bf16*)(ws + W_W2) + (size_t)i * D * 128, 128, 128));
        tjob_run(F, mkjob(((const float*)ldptr(ptab, 13)) + (size_t)i * 64 * D, 64, D, D, (bf16*)(ws + W_A2) + (size_t)i * D * 128, 128, 128));
        tjob_run(F, mkjob(((const float*)ldptr(ptab, 15)) + (size_t)i * 160 * D, 160, D, D, (bf16*)(ws + W_G2) + (size_t)i * D * 256, 256, 256));
}
__device__ __forceinline__ void prologue_ffn_jobs(const Fr& F, LAS unsigned long long* ptab, unsigned char* ws, const int l) {
        { TJob j = mkjob(((const float*)ldptr(ptab, 2)) + (size_t)l * D * 2 * FF, D, 2 * FF, 2 * FF, (bf16*)(ws + W_FIN) + (size_t)l * 2 * FF * D, D, D); j.sc2 = ((const float*)ldptr(ptab, 1)) + (size_t)(l * 4 + 2) * D; tjob_run(F, j); }
        tjob_run(F, mkjob(((const float*)ldptr(ptab, 5)) + (size_t)l * FF * D, FF, D, D, (bf16*)(ws + W_FOUT) + (size_t)l * D * FF, FF, FF));
}
__device__ __forceinline__ void prologue_tables(const Fr& F, unsigned char* ws);
__device__ __forceinline__ void prologue(const Fr& F, LAS unsigned long long* ptab, unsigned char* ws) {
    LAS int* cnt = (LAS int*)(F.lds + TJ_CNT);
    if (F.tid == 0) { cnt[0] = 0; cnt[1] = 0; }
    for (int i = 0; i < 2; ++i) {
        prologue_rwkv_jobs(F, ptab, ws, i); prologue_ffn_jobs(F, ptab, ws, i);
        if (F.tid == 0) cnt[2 + i] = cnt[1];
    }
    for (int i = 0; i < 2; ++i) {
        { TJob j = mkjob(((const float*)ldptr(ptab, 26)) + (size_t)i * D * 384, D, 384, 384, (bf16*)(ws + W_QD) + (size_t)i * 512 * D, D, D); j.sc2 = ((const float*)ldptr(ptab, 1)) + (size_t)((2 + i) * 4) * D; tjob_run(F, j); }
        zero_rows(F, (bf16*)(ws + W_QD) + (size_t)i * 512 * D + (size_t)384 * D, (size_t)128 * D);
        { TJob j = mkjob(((const float*)ldptr(ptab, 28)) + (size_t)i * 384 * 1536, 384, 1536, 1536, (bf16*)(ws + W_QU) + (size_t)i * 1536 * 384, 384, 384); j.sc2 = ((const float*)ldptr(ptab, 27)) + (size_t)i * 384; tjob_run(F, j); }
        tjob_run(F, mkjob(((const float*)ldptr(ptab, 29)) + (size_t)i * D * D, D, D, D, (bf16*)(ws + W_OM) + (size_t)i * D * D, D, D));
    }
    { TJob j = mkjob(((const float*)ldptr(ptab, 23)), D, 288, 288, (bf16*)(ws + W_KVD), D, D); j.sc2 = (const float*)ldptr(ptab, 22); tjob_run(F, j); }
    zero_rows(F, (bf16*)(ws + W_KVD) + (size_t)288 * D, (size_t)224 * D);
    { TJob j = mkjob(((const float*)ldptr(ptab, 25)), 256, 2048, 64, (bf16*)(ws + W_KVUK), 256, 256); j.ngroups = 16; j.gstride = 128; j.goff = 0; tjob_run(F, j);
      j.dst = (bf16*)(ws + W_KVUV); j.goff = 64; tjob_run(F, j); }
    prologue_ffn_jobs(F, ptab, ws, 2);
    if (F.tid == 0) cnt[4] = cnt[1];
    prologue_ffn_jobs(F, ptab, ws, 3);
    if (F.tid == 0) cnt[5] = cnt[1];
    __syncthreads();
    if (F.bid == 0) { GAS int* gt = (GAS int*)(ws + WS_CTL + WS_TJ); const LAS int* lt = (const LAS int*)(F.lds + TJ_TAB);
        for (int q = F.tid; q < 64 * 20 + 8; q += NTHREADS) gt[q] = lt[q]; }
    tjob_exec(F, 0, cnt[2]);
    prologue_tables(F, ws);
}
__device__ __forceinline__ void prologue_tables(const Fr& F, unsigned char* ws) {
    { float* z = (float*)(ws + WS_SSQ); for (int i = F.bid * NTHREADS + F.tid; i < 3 * M; i += F.nb * NTHREADS) z[i] = 0.f; }
    float* ct = (float*)(ws + WS_COS); float* st = (float*)(ws + WS_SIN);
    for (int i = F.bid * NTHREADS + F.tid; i < T * 16; i += F.nb * NTHREADS) {
        const int t = i >> 4, f = i & 15;
        const float inv = (float)(1.0 / pow(10000.0, (double)(2 * f) / 32.0));
        const float ang = (float)t * inv;
        ct[i] = (float)cos((double)ang); st[i] = (float)sin((double)ang);
    }
}

__device__ __forceinline__ void prologue_side(const Fr& F, unsigned char* ws, const int part) {
    if (F.bid < HALO_WGS || F.nb <= HALO_WGS) return;
    { const GAS int* gt = (const GAS int*)(ws + WS_CTL + WS_TJ); LAS int* lt = (LAS int*)(F.lds + TJ_TAB);
      for (int q = F.tid; q < 64 * 20 + 8; q += NTHREADS) lt[q] = gt[q]; }
    __syncthreads();
    const LAS int* cnt = (const LAS int*)(F.lds + TJ_CNT);
    Fr G = F; G.bid = F.bid - HALO_WGS; G.nb = F.nb - HALO_WGS; G.gw = G.bid * NWAVES + F.wave; G.ngw = G.nb * NWAVES;
    tjob_exec(G, cnt[1 + part], cnt[2 + part]);
    __syncthreads();
}
struct pg8_Unit { int pm, pn; };
struct EpiBf16 { static constexpr bool PERM = true, WHOLE = false; bf16* O; int ldc, nvalid;
    __device__ __forceinline__ void st8(int r, int c, f32x4 a, f32x4 b) const { u32x4 w; w.x = pk2(a[0], a[1]); w.y = pk2(a[2], a[3]); w.z = pk2(b[0], b[1]); w.w = pk2(b[2], b[3]); *(u32x4*)(O + (size_t)r * ldc + c) = w; }
    __device__ __forceinline__ void operator()(int r, int c, f32x4 v) const { u32x2 w; w.x = pk2(v[0], v[1]); w.y = pk2(v[2], v[3]); *(u32x2*)(O + (size_t)r * ldc + c) = w; } };
struct EpiVT { static constexpr bool PERM = true, WHOLE = false; bf16* O;
    __device__ __forceinline__ size_t at(int r, int c) const { return ((((size_t)(r >> 6) * (M / 64) + (c >> 6)) * 64 + (r & 63)) * 64) + (c & 63); }
    __device__ __forceinline__ void st8(int r, int c, f32x4 a, f32x4 b) const { u32x4 w; w.x = pk2(a[0], a[1]); w.y = pk2(a[2], a[3]); w.z = pk2(b[0], b[1]); w.w = pk2(b[2], b[3]); *(u32x4*)(O + at(r, c)) = w; }
    __device__ __forceinline__ void operator()(int r, int c, f32x4 v) const { u32x2 w; w.x = pk2(v[0], v[1]); w.y = pk2(v[2], v[3]); *(u32x2*)(O + at(r, c)) = w; } };
struct EpiF32RS { static constexpr bool PERM = false, WHOLE = false; float* O; int ldc; const float* rs;
    __device__ __forceinline__ void operator()(int r, int c, f32x4 v) const { *(f32x4*)(O + (size_t)r * ldc + c) = v * rs_inv4(rs, (size_t)r); } };
struct EpiCqRaw { static constexpr bool PERM = true, WHOLE = false; bf16* O; const float* rs; float* ssq; int nssq;
    __device__ __forceinline__ void st8(int r, int c, f32x4 a, f32x4 b) const { const float s = rs_inv4(rs, (size_t)r); a = a * s; b = b * s;
        u32x4 w; w.x = pk2(a[0], a[1]); w.y = pk2(a[2], a[3]); w.z = pk2(b[0], b[1]); w.w = pk2(b[2], b[3]); *(u32x4*)(O + (size_t)r * 512 + c) = w;
        if (c < nssq) { const float q = ((a[0] * a[0] + a[1] * a[1]) + (a[2] * a[2] + a[3] * a[3])) + ((b[0] * b[0] + b[1] * b[1]) + (b[2] * b[2] + b[3] * b[3]));
            __hip_atomic_fetch_add(ssq + r, q, __ATOMIC_RELAXED, __HIP_MEMORY_SCOPE_AGENT); } } };
struct EpiF32 { static constexpr bool PERM = false, WHOLE = false; float* O; int ldc, nvalid;
    __device__ __forceinline__ void operator()(int r, int c, f32x4 v) const { *(f32x4*)(O + (size_t)r * ldc + c) = v; } };
template <bool DECAY> struct EpiSigT { static constexpr bool PERM = true, WHOLE = true; bf16* O; const float* c0;
    __device__ __forceinline__ void tile(f32x4 (&acc)[2][2][4][2], const pg8_Unit& u, int wr, int wc, int fr, int fq) const {
        f32x4 cl[2][2];
#pragma unroll
        for (int bj = 0; bj < 2; ++bj)
#pragma unroll
            for (int n = 0; n < 2; ++n) cl[bj][n] = *(const GAS f32x4*)((const GAS float*)c0 + u.pn * 256 + bj * 128 + wc * 32 + 8 * fq + 4 * n) * -1.4426950408889634f;
#pragma unroll
        for (int ai = 0; ai < 2; ++ai)
#pragma unroll
            for (int m = 0; m < 4; ++m) { const size_t r = (size_t)(u.pm * 256 + ai * 128 + wr * 64 + m * 16 + fr);
#pragma unroll
                for (int bj = 0; bj < 2; ++bj) { f32x4 o[2];
#pragma unroll
                    for (int n = 0; n < 2; ++n) { const f32x4 z = acc[ai][bj][m][n] * -1.4426950408889634f + cl[bj][n];
                        f32x4 ex; ex[0] = __builtin_amdgcn_exp2f(z[0]); ex[1] = __builtin_amdgcn_exp2f(z[1]); ex[2] = __builtin_amdgcn_exp2f(z[2]); ex[3] = __builtin_amdgcn_exp2f(z[3]);
                        const f32x4 den = ex + 1.f;
                        f32x4 rc; rc[0] = __builtin_amdgcn_rcpf(den[0]); rc[1] = __builtin_amdgcn_rcpf(den[1]); rc[2] = __builtin_amdgcn_rcpf(den[2]); rc[3] = __builtin_amdgcn_rcpf(den[3]);
                        o[n] = DECAY ? rc * -0.6065306597126334f : rc; }
                    u32x4 w; w.x = pk2(o[0][0], o[0][1]); w.y = pk2(o[0][2], o[0][3]); w.z = pk2(o[1][0], o[1][1]); w.w = pk2(o[1][2], o[1][3]);
                    *(GAS u32x4*)((GAS bf16*)O + r * D + u.pn * 256 + bj * 128 + wc * 32 + 8 * fq) = w; } }
    } };
struct EpiQRope { static constexpr bool PERM = false, WHOLE = true; bf16* O; const float* ct; const float* st; int tok0; const float* ssq;
    __device__ __forceinline__ void tile(const f32x4 (&acc)[2][2][4][2], const pg8_Unit& u, int wr, int wc, int fr, int fq) const {
        const float sc = 0.1472444460259031f;
#pragma unroll
        for (int bj = 0; bj < 2; ++bj) {
            const int col = u.pn * 256 + bj * 128 + wc * 32 + 4 * fq; const bool rope = ((col >> 5) % 3) == 2;
#pragma unroll
            for (int ai = 0; ai < 2; ++ai)
#pragma unroll
                for (int m = 0; m < 4; ++m) {
                    const int row = u.pm * 256 + ai * 128 + wr * 64 + m * 16 + fr; f32x4 x1 = acc[ai][bj][m][0], x2 = acc[ai][bj][m][1];
                    if (rope) { const int t = (tok0 + row) % T; const f32x4 cs = *(const f32x4*)(ct + t * 16 + 4 * fq), sn = *(const f32x4*)(st + t * 16 + 4 * fq);
                        const f32x4 y1 = x1 * cs - x2 * sn, y2 = x1 * sn + x2 * cs; x1 = y1; x2 = y2; }
                    const float rq = sc * rsqrtf(ssq[row] * (1.f / 384.f) + NORM_EPS); x1 = x1 * rq; x2 = x2 * rq;
                    u32x2 w1, w2; w1.x = pk2(x1[0], x1[1]); w1.y = pk2(x1[2], x1[3]); w2.x = pk2(x2[0], x2[1]); w2.y = pk2(x2[2], x2[3]);
                    GAS bf16* op = (GAS bf16*)O + (size_t)row * 1536 + col; *(GAS u32x2*)op = w1; *(GAS u32x2*)(op + 16) = w2;
                }
        }
    } };
struct EpiFfn { static constexpr bool PERM = true, WHOLE = true; bf16* H; const float* cw; const float* cb; const float* Gh; const float* rs;
    __device__ __forceinline__ void tile(f32x4 (&acc)[2][2][4][2], const pg8_Unit& u, int wr, int wc, int fr, int fq) const {
        const int tb = u.pm * 256 + wr * 128 + fr * 8, f0 = u.pn * 128 + wc * 32 + fq * 8, grp = u.pm * 2 + wr; const bool seq0 = ((grp * 128) % T) == 0;
        f32x4 pr[8], hp2 = {0.f, 0.f, 0.f, 0.f}, hp1 = hp2, hr2[2], hr1[2], cwv[2][3], cbv[2];
#pragma unroll
        for (int e = 0; e < 8; ++e) pr[e] = *(const GAS f32x4*)((const GAS float*)rs + (size_t)(tb + e) * 4);
#pragma unroll
        for (int n = 0; n < 2; ++n) { hr2[n] = (f32x4){0.f, 0.f, 0.f, 0.f}; hr1[n] = hr2[n]; }
        if (fr == 0 && !seq0) { hp2 = *(const GAS f32x4*)((const GAS float*)rs + (size_t)(tb - 2) * 4); hp1 = *(const GAS f32x4*)((const GAS float*)rs + (size_t)(tb - 1) * 4);
#pragma unroll
            for (int n = 0; n < 2; ++n) { hr2[n] = *(const GAS f32x4*)((const GAS float*)Gh + (size_t)(2 * grp) * FF + f0 + 4 * n); hr1[n] = *(const GAS f32x4*)((const GAS float*)Gh + (size_t)(2 * grp + 1) * FF + f0 + 4 * n); }
        }
#pragma unroll
        for (int n = 0; n < 2; ++n) { cwv[n][0] = *(const GAS f32x4*)((const GAS float*)cw + f0 + 4 * n); cwv[n][1] = *(const GAS f32x4*)((const GAS float*)cw + FF + f0 + 4 * n); cwv[n][2] = *(const GAS f32x4*)((const GAS float*)cw + 2 * FF + f0 + 4 * n); cbv[n] = *(const GAS f32x4*)((const GAS float*)cb + f0 + 4 * n); }
        { f32x4 ra, rb;
#pragma unroll
          for (int e = 0; e < 4; ++e) { ra[e] = rsqrtf(((pr[e][0] + pr[e][1]) + (pr[e][2] + pr[e][3])) * (1.f / 1024.f) + NORM_EPS); rb[e] = rsqrtf(((pr[4 + e][0] + pr[4 + e][1]) + (pr[4 + e][2] + pr[4 + e][3])) * (1.f / 1024.f) + NORM_EPS); }
#pragma unroll
          for (int m = 0; m < 4; ++m)
#pragma unroll
            for (int bj = 0; bj < 2; ++bj)
#pragma unroll
              for (int n = 0; n < 2; ++n) { acc[0][bj][m][n] = acc[0][bj][m][n] * ra[m]; acc[1][bj][m][n] = acc[1][bj][m][n] * rb[m]; } }
        f32x4 h2[2], h1[2];
        { const float r2 = rsqrtf(((hp2[0] + hp2[1]) + (hp2[2] + hp2[3])) * (1.f / 1024.f) + NORM_EPS), r1 = rsqrtf(((hp1[0] + hp1[1]) + (hp1[2] + hp1[3])) * (1.f / 1024.f) + NORM_EPS);
#pragma unroll
          for (int n = 0; n < 2; ++n) { h2[n] = hr2[n] * r2; h1[n] = hr1[n] * r1; } }
#pragma unroll
        for (int n = 0; n < 2; ++n) {
            const f32x4 c0 = cwv[n][0], c1 = cwv[n][1], c2 = cwv[n][2], bv = cbv[n];
            f32x4 gm1, gm2;
#pragma unroll
            for (int e = 0; e < 4; ++e) {
                const float a7 = acc[1][0][3][n][e], a6 = acc[1][0][2][n][e];
                const float t1 = dpp_mov0<0x111>(a7), t2 = dpp_mov0<0x111>(a6);
                gm1[e] = fr > 0 ? t1 : h1[n][e]; gm2[e] = fr > 0 ? t2 : h2[n][e]; }
#pragma unroll
            for (int idx = 7; idx >= 0; --idx) {
                const f32x4 g0 = acc[idx >> 2][0][idx & 3][n];
                const f32x4 p1 = idx >= 1 ? acc[(idx - 1) >> 2][0][(idx - 1) & 3][n] : gm1;
                const f32x4 p2 = idx >= 2 ? acc[(idx - 2) >> 2][0][(idx - 2) & 3][n] : (idx == 1 ? gm1 : gm2);
                const f32x4 gc = bv + p2 * c0 + p1 * c1 + g0 * c2, up = acc[idx >> 2][1][idx & 3][n];
                const f32x4 zz = gc * (gc * gc * -0.10294324f + -2.3022082f), xu = gc * up;
                f32x4 ex; ex[0] = __builtin_amdgcn_exp2f(zz[0]); ex[1] = __builtin_amdgcn_exp2f(zz[1]); ex[2] = __builtin_amdgcn_exp2f(zz[2]); ex[3] = __builtin_amdgcn_exp2f(zz[3]);
                const f32x4 den = ex + 1.f;
                f32x4 rc; rc[0] = __builtin_amdgcn_rcpf(den[0]); rc[1] = __builtin_amdgcn_rcpf(den[1]); rc[2] = __builtin_amdgcn_rcpf(den[2]); rc[3] = __builtin_amdgcn_rcpf(den[3]);
                acc[idx >> 2][0][idx & 3][n] = xu * rc;
            }
        }
#pragma unroll
        for (int idx = 0; idx < 8; ++idx) { const f32x4 a = acc[idx >> 2][0][idx & 3][0], b = acc[idx >> 2][0][idx & 3][1];
            u32x4 w; w.x = pk2(a[0], a[1]); w.y = pk2(a[2], a[3]); w.z = pk2(b[0], b[1]); w.w = pk2(b[2], b[3]);
            *(GAS u32x4*)((GAS bf16*)H + (size_t)(tb + idx) * FF + f0) = w; }
    } };
constexpr size_t WS_RCNT = 32 * 1024;
constexpr size_t WS_SSQX = 1 * MiB + 512 * 1024;
constexpr size_t WS_RSLOT = 64 * 1024;
template <bool SF32, bool DF32, bool SQ> struct EpiResid { static constexpr bool PERM = true, WHOLE = true;
    const void* Xs; void* Xd; const float* g; float* slots; unsigned* cnt; unsigned want; float* ssq; LAS unsigned char* lds;
    __device__ __forceinline__ void tile(f32x4 (&acc)[2][2][4][2], const pg8_Unit& u, int wr, int wc, int fr, int fq) const {
        LAS float* P = (LAS float*)(lds + 131072); LAS float* S = P + 1024;
        const int wid = wr * 4 + wc, lane = fq * 16 + fr;
        u32x4 xw[4][2]; f32x4 gv[2][2];
#define ER_LOADX(idx_) do { if (!SF32) { _Pragma("unroll") for (int bj = 0; bj < 2; ++bj) \
            xw[(idx_) & 3][bj] = *(const GAS u32x4*)((const GAS bf16*)Xs + (size_t)(u.pm * 256 + ((idx_) >> 2) * 128 + wr * 64 + ((idx_) & 3) * 16 + fr) * D + u.pn * 256 + bj * 128 + wc * 32 + 8 * fq); } } while (0)
        ER_LOADX(0); ER_LOADX(1); ER_LOADX(2); ER_LOADX(3);
        f32x4 xf[2][2][2];
#define ER_LOADF(idx_) do { if (SF32) { _Pragma("unroll") for (int bj = 0; bj < 2; ++bj) { const GAS float* sp_ = (const GAS float*)Xs + (size_t)(u.pm * 256 + ((idx_) >> 2) * 128 + wr * 64 + ((idx_) & 3) * 16 + fr) * D + u.pn * 256 + bj * 128 + wc * 32 + 8 * fq; \
            xf[(idx_) & 1][bj][0] = *(const GAS f32x4*)sp_; xf[(idx_) & 1][bj][1] = *(const GAS f32x4*)(sp_ + 4); } } } while (0)
        ER_LOADF(0); ER_LOADF(1);
#pragma unroll
        for (int bj = 0; bj < 2; ++bj)
#pragma unroll
            for (int n = 0; n < 2; ++n) gv[bj][n] = *(const GAS f32x4*)((const GAS float*)g + u.pn * 256 + bj * 128 + wc * 32 + 8 * fq + 4 * n);
#pragma unroll
        for (int ai = 0; ai < 2; ++ai)
#pragma unroll
            for (int m = 0; m < 4; ++m) { float q = 0.f;
#pragma unroll
                for (int bj = 0; bj < 2; ++bj)
#pragma unroll
                    for (int n = 0; n < 2; ++n) { const f32x4 x = acc[ai][bj][m][n]; q += (x[0] * x[0] + x[1] * x[1]) + (x[2] * x[2] + x[3] * x[3]); }
                q += __shfl_xor(q, 16); q += __shfl_xor(q, 32);
                if (fq == 0) P[(ai * 128 + wr * 64 + m * 16 + fr) * 4 + wc] = q; }
        asm volatile("s_waitcnt lgkmcnt(0)" ::: "memory"); __builtin_amdgcn_s_barrier(); asm volatile("" ::: "memory");
        const int row = wid * 32 + (lane & 31);
        unsigned* sl = (unsigned*)slots + (size_t)(u.pm * 256 + row) * 4;
        if (lane < 32) { const f32x4 pq = *(const LAS f32x4*)(P + row * 4);
            __hip_atomic_store(sl + u.pn, (__float_as_uint((pq[0] + pq[1]) + (pq[2] + pq[3])) & ~15u) | want, __ATOMIC_RELAXED, __HIP_MEMORY_SCOPE_AGENT); }
#pragma unroll
        for (int ai = 0; ai < 2; ++ai)
#pragma unroll
            for (int bj = 0; bj < 2; ++bj)
#pragma unroll
                for (int m = 0; m < 4; ++m) { acc[ai][bj][m][0] = acc[ai][bj][m][0] * gv[bj][0]; acc[ai][bj][m][1] = acc[ai][bj][m][1] * gv[bj][1]; }
        { bool ok = lane >= 32; unsigned w0 = 0u, w1 = 0u, w2 = 0u, w3 = 0u, sp = 0u;
          for (;;) {
              if (!ok) { w0 = __hip_atomic_load(sl + 0, __ATOMIC_RELAXED, __HIP_MEMORY_SCOPE_AGENT); w1 = __hip_atomic_load(sl + 1, __ATOMIC_RELAXED, __HIP_MEMORY_SCOPE_AGENT);
                         w2 = __hip_atomic_load(sl + 2, __ATOMIC_RELAXED, __HIP_MEMORY_SCOPE_AGENT); w3 = __hip_atomic_load(sl + 3, __ATOMIC_RELAXED, __HIP_MEMORY_SCOPE_AGENT);
                         ok = ((w0 & 15u) == want) && ((w1 & 15u) == want) && ((w2 & 15u) == want) && ((w3 & 15u) == want); }
              if (__all(ok)) break;
              __builtin_amdgcn_s_sleep(1); if (++sp > (1u << 22)) break; }
          if (lane < 32) { const float t = (__uint_as_float(w0 & ~15u) + __uint_as_float(w1 & ~15u)) + (__uint_as_float(w2 & ~15u) + __uint_as_float(w3 & ~15u)); S[row] = rsqrtf(t * (1.f / D) + NORM_EPS); } }
        asm volatile("s_waitcnt vmcnt(0) lgkmcnt(0)" ::: "memory"); __builtin_amdgcn_s_barrier(); asm volatile("" ::: "memory");
#pragma unroll
        for (int ai = 0; ai < 2; ++ai) {
#pragma unroll
            for (int m = 0; m < 4; ++m) { const int rl = ai * 128 + wr * 64 + m * 16 + fr; const float ri = S[rl]; const size_t r = (size_t)(u.pm * 256 + rl); float q2 = 0.f;
                u32x4 xc[2]; xc[0] = xw[m][0]; xc[1] = xw[m][1];
                if (ai == 0) { asm volatile("" : "+v"(xc[0]), "+v"(xc[1])); ER_LOADX(4 + m); }
                f32x4 fc[2][2];
                if (SF32) { const int idx = ai * 4 + m; fc[0][0] = xf[idx & 1][0][0]; fc[0][1] = xf[idx & 1][0][1]; fc[1][0] = xf[idx & 1][1][0]; fc[1][1] = xf[idx & 1][1][1];
                    asm volatile("" : "+v"(fc[0][0]), "+v"(fc[0][1]), "+v"(fc[1][0]), "+v"(fc[1][1])); if (idx + 2 < 8) ER_LOADF(idx + 2); }
#pragma unroll
                for (int bj = 0; bj < 2; ++bj) { const size_t off = r * D + u.pn * 256 + bj * 128 + wc * 32 + 8 * fq;
                    f32x4 xa, xb;
                    if (SF32) { xa = fc[bj][0]; xb = fc[bj][1]; }
                    else { const u32x4 xv = xc[bj]; xa = (f32x4){bflo(xv.x), bfhi(xv.x), bflo(xv.y), bfhi(xv.y)}; xb = (f32x4){bflo(xv.z), bfhi(xv.z), bflo(xv.w), bfhi(xv.w)}; }
                    const f32x4 ya = xa + acc[ai][bj][m][0] * ri, yb = xb + acc[ai][bj][m][1] * ri;
                    if (SQ) q2 += ((ya[0] * ya[0] + ya[1] * ya[1]) + (ya[2] * ya[2] + ya[3] * ya[3])) + ((yb[0] * yb[0] + yb[1] * yb[1]) + (yb[2] * yb[2] + yb[3] * yb[3]));
                    if (DF32) { *(GAS f32x4*)((GAS float*)Xd + off) = ya; *(GAS f32x4*)((GAS float*)Xd + off + 4) = yb; }
                    else { u32x4 w; w.x = pk2(ya[0], ya[1]); w.y = pk2(ya[2], ya[3]); w.z = pk2(yb[0], yb[1]); w.w = pk2(yb[2], yb[3]); *(GAS u32x4*)((GAS bf16*)Xd + off) = w; } }
                if (SQ) { q2 += __shfl_xor(q2, 16); q2 += __shfl_xor(q2, 32); if (fq == 0) P[rl * 4 + wc] = q2; } } }
#undef ER_LOADX
#undef ER_LOADF
        if (SQ) {
            asm volatile("s_waitcnt lgkmcnt(0)" ::: "memory"); __builtin_amdgcn_s_barrier(); asm volatile("" ::: "memory");
            if (lane < 32) { const f32x4 pq = *(const LAS f32x4*)(P + row * 4); *(GAS float*)((GAS float*)ssq + ((size_t)(u.pm * 256 + row) * 4 + u.pn)) = (pq[0] + pq[1]) + (pq[2] + pq[3]); }
            asm volatile("s_waitcnt lgkmcnt(0)" ::: "memory"); __builtin_amdgcn_s_barrier(); asm volatile("" ::: "memory");
        }
    } };
struct EpiKvd { static constexpr bool PERM = false, WHOLE = true; bf16* ckv; bf16* KR; const float* g; const float* ct; const float* st; const float* rs; LAS unsigned char* lds;
    __device__ __forceinline__ void tile(f32x4 (&acc)[2][2][4][2], const pg8_Unit& u, int wr, int wc, int fr, int fq) const {
        LAS float* P = (LAS float*)(lds + 131072);
        if (u.pn == 0) {
#pragma unroll
            for (int ai = 0; ai < 2; ++ai)
#pragma unroll
                for (int m = 0; m < 4; ++m) { float q = 0.f; const float rv = rs_inv4(rs, (size_t)(u.pm * 256 + ai * 128 + wr * 64 + m * 16 + fr));
#pragma unroll
                    for (int bj = 0; bj < 2; ++bj)
#pragma unroll
                        for (int n = 0; n < 2; ++n) { acc[ai][bj][m][n] = acc[ai][bj][m][n] * rv; const f32x4 x = acc[ai][bj][m][n]; q += (x[0] * x[0] + x[1] * x[1]) + (x[2] * x[2] + x[3] * x[3]); }
                    q += __shfl_xor(q, 16); q += __shfl_xor(q, 32);
                    if (fq == 0) P[(ai * 128 + wr * 64 + m * 16 + fr) * 4 + wc] = q; }
            asm volatile("s_waitcnt lgkmcnt(0)" ::: "memory"); __builtin_amdgcn_s_barrier(); asm volatile("" ::: "memory");
#pragma unroll
            for (int ai = 0; ai < 2; ++ai)
#pragma unroll
                for (int m = 0; m < 4; ++m) { const int rl = ai * 128 + wr * 64 + m * 16 + fr; const f32x4 pq = *(const LAS f32x4*)(P + rl * 4);
                    const float ri = rsqrtf(((pq[0] + pq[1]) + (pq[2] + pq[3])) * (1.f / 256.f) + NORM_EPS);
#pragma unroll
                    for (int bj = 0; bj < 2; ++bj)
#pragma unroll
                        for (int n = 0; n < 2; ++n) { const int c = bj * 128 + wc * 32 + 16 * n + 4 * fq; const f32x4 gv = *(const GAS f32x4*)((const GAS float*)g + c), x = acc[ai][bj][m][n] * ri * gv;
                            u32x2 w; w.x = pk2(x[0], x[1]); w.y = pk2(x[2], x[3]); *(GAS u32x2*)((GAS bf16*)ckv + (size_t)(u.pm * 256 + rl) * 256 + c) = w; } }
            asm volatile("s_waitcnt lgkmcnt(0)" ::: "memory"); __builtin_amdgcn_s_barrier(); asm volatile("" ::: "memory");
        } else if (wc == 0) {
#pragma unroll
            for (int ai = 0; ai < 2; ++ai)
#pragma unroll
                for (int m = 0; m < 4; ++m) { const int row = u.pm * 256 + ai * 128 + wr * 64 + m * 16 + fr, t = row % T;
                    const float rv = rs_inv4(rs, (size_t)row); const f32x4 x1 = acc[ai][0][m][0] * rv, x2 = acc[ai][0][m][1] * rv;
                    const f32x4 cs = *(const GAS f32x4*)((const GAS float*)ct + t * 16 + 4 * fq), sn = *(const GAS f32x4*)((const GAS float*)st + t * 16 + 4 * fq);
                    const f32x4 y1 = x1 * cs - x2 * sn, y2 = x1 * sn + x2 * cs;
                    u32x2 w1, w2; w1.x = pk2(y1[0], y1[1]); w1.y = pk2(y1[2], y1[3]); w2.x = pk2(y2[0], y2[1]); w2.y = pk2(y2[2], y2[3]);
                    GAS bf16* op = (GAS bf16*)KR + (size_t)row * 32 + 4 * fq; *(GAS u32x2*)op = w1; *(GAS u32x2*)(op + 16) = w2; }
        }
    } };
struct EpiA6 { static constexpr bool PERM = true, WHOLE = true; const unsigned short* Y; const bf16* V; const float* CT; const float* lw; const float* lb; bf16* out; LAS unsigned char* lds;
    __device__ __forceinline__ void tile(f32x4 (&acc)[2][2][4][2], const pg8_Unit& u, int wr, int wc, int fr_in, int fq_in) const {
        int t_ = (int)__builtin_amdgcn_workitem_id_x(); asm volatile("" : "+v"(t_)); const int fr = t_ & 15, fq = (t_ >> 4) & 3; (void)fr_in; (void)fq_in;
        LAS float* Tb = (LAS float*)(lds + 131072);
#pragma unroll
        for (int bj = 0; bj < 2; ++bj) {
            const int col0 = u.pn * 256 + bj * 128 + wc * 32 + 8 * fq, head = col0 >> 6;
            const f32x4 lw0 = *(const GAS f32x4*)((const GAS float*)lw + col0), lw1 = *(const GAS f32x4*)((const GAS float*)lw + col0 + 4);
            const f32x4 lb0 = *(const GAS f32x4*)((const GAS float*)lb + col0), lb1 = *(const GAS f32x4*)((const GAS float*)lb + col0 + 4);
#pragma unroll
            for (int ai = 0; ai < 2; ++ai) {
                const size_t row0 = (size_t)(u.pm * 256 + ai * 128 + wr * 64 + fr);
                u32x4 yk[4], vk[4];
#pragma unroll
                for (int m = 0; m < 4; ++m) yk[m] = *(const GAS u32x4*)((const GAS unsigned short*)Y + (row0 + 16 * m) * D + col0);
#pragma unroll
                for (int m = 0; m < 4; ++m) vk[m] = *(const GAS u32x4*)((const GAS bf16*)V + (row0 + 16 * m) * D + col0);
#pragma unroll
                for (int m = 0; m < 4; ++m) { float s1 = 0.f, s2 = 0.f;
#pragma unroll
                    for (int e = 0; e < 4; ++e) { const h16x2_t hp = __builtin_bit_cast(h16x2_t, (unsigned)yk[m][e]); const float a = (float)hp[0], b = (float)hp[1]; s1 += a + b; s2 += a * a + b * b; }
                    s1 += __shfl_xor(s1, 16); s1 += __shfl_xor(s1, 32); s2 += __shfl_xor(s2, 16); s2 += __shfl_xor(s2, 32);
                    if (fq == 0) { LAS float* tp = Tb + ((ai * 128 + wr * 64 + m * 16 + fr) * 4 + wc) * 2; tp[0] = s1; tp[1] = s2; } }
                asm volatile("s_waitcnt lgkmcnt(0)" ::: "memory"); __builtin_amdgcn_s_barrier(); asm volatile("" ::: "memory");
#pragma unroll
                for (int m = 0; m < 4; ++m) { const int rl = ai * 128 + wr * 64 + m * 16 + fr; const size_t row = row0 + 16 * m;
                    const LAS float* te = Tb + (rl * 4 + (wc & ~1)) * 2;
                    const float S1 = te[0] + te[2], S2 = te[1] + te[3];
                    const float mean = S1 * (1.f / 64.f), var = fmaxf(S2 * (1.f / 64.f) - mean * mean, 0.f), rstd = rsqrtf(var + LNX_EPS);
                    const float ct = ((const GAS float*)CT)[row * 16 + head];
                    float y[8], v[8];
#pragma unroll
                    for (int e = 0; e < 4; ++e) { const h16x2_t hp = __builtin_bit_cast(h16x2_t, (unsigned)yk[m][e]); y[2 * e] = (float)hp[0]; y[2 * e + 1] = (float)hp[1]; const unsigned uv = vk[m][e]; v[2 * e] = bflo(uv); v[2 * e + 1] = bfhi(uv); }
                    const f32x4 ya = {y[0], y[1], y[2], y[3]}, yb = {y[4], y[5], y[6], y[7]}, va = {v[0], v[1], v[2], v[3]}, vb = {v[4], v[5], v[6], v[7]};
                    const f32x4 oa = ((ya - mean) * rstd * lw0 + lb0 + va * ct) * acc[ai][bj][m][0], ob = ((yb - mean) * rstd * lw1 + lb1 + vb * ct) * acc[ai][bj][m][1];
                    u32x4 w; w.x = pk2(oa[0], oa[1]); w.y = pk2(oa[2], oa[3]); w.z = pk2(ob[0], ob[1]); w.w = pk2(ob[2], ob[3]);
                    *(GAS u32x4*)((GAS bf16*)out + row * D + col0) = w; }
                asm volatile("s_waitcnt lgkmcnt(0)" ::: "memory"); __builtin_amdgcn_s_barrier(); asm volatile("" ::: "memory");
            }
        }
    } };
struct EpiBf16RS { static constexpr bool PERM = true, WHOLE = true; bf16* O; int ldc; const float* rs;
    __device__ __forceinline__ void tile(f32x4 (&acc)[2][2][4][2], const pg8_Unit& u, int wr, int wc, int fr, int fq) const {
        float rv[2][4];
#pragma unroll
        for (int ai = 0; ai < 2; ++ai)
#pragma unroll
            for (int m = 0; m < 4; ++m) rv[ai][m] = rs_inv4(rs, (size_t)(u.pm * 256 + ai * 128 + wr * 64 + m * 16 + fr));
#pragma unroll
        for (int ai = 0; ai < 2; ++ai)
#pragma unroll
            for (int m = 0; m < 4; ++m) { const size_t r = (size_t)(u.pm * 256 + ai * 128 + wr * 64 + m * 16 + fr);
#pragma unroll
                for (int bj = 0; bj < 2; ++bj) { const f32x4 a = acc[ai][bj][m][0] * rv[ai][m], b = acc[ai][bj][m][1] * rv[ai][m];
                    u32x4 w; w.x = pk2(a[0], a[1]); w.y = pk2(a[2], a[3]); w.z = pk2(b[0], b[1]); w.w = pk2(b[2], b[3]);
                    *(GAS u32x4*)((GAS bf16*)O + r * ldc + u.pn * 256 + bj * 128 + wc * 32 + 8 * fq) = w; } }
    } };
namespace pg8 {
typedef short bf16x8 __attribute__((ext_vector_type(8)));
constexpr int BM = 256, BK = 64, HALF = 128, HTB = HALF * BK * 2, STAGE_BYTES = 8 * HTB, NXCD = 8, WGM = 8;
__host__ __device__ __forceinline__ int lds_byte(int r, int c) { const int st = (r >> 4) * 2 + (c >> 5), rr = r & 15, cc = c & 31, ob = rr * 64 + cc * 2; return st * 1024 + (ob ^ (((ob >> 9) & 1) << 5)); }
__host__ __device__ __forceinline__ void stage_rc(int b, int& R, int& C) { const int st = b / 1024, sb = b % 1024, swz = sb ^ (((sb >> 9) & 1) << 5); R = (st >> 1) * 16 + swz / 64; C = (st & 1) * 32 + (swz % 64) / 2; }
__host__ __device__ __forceinline__ int perm32(int rho) { const int n = rho >> 4, i = rho & 15; return 8 * (i >> 2) + 4 * n + (i & 3); }
typedef ::pg8_Unit Unit;
struct Gemm { const bf16* A; const bf16* Bt; int M, N, K, lda, ldb; size_t tA, hA, tB, hB; };
template <int AMAP> __device__ __forceinline__ int amap_row(int R) { if (AMAP == 1) return 128 * (R >> 6) + 8 * (R & 15) + ((R >> 4) & 3); if (AMAP == 2) { const int t = 128 * (R >> 1) - 2 + (R & 1); return t < 0 ? 0 : t; } return R; }
struct StaticOrder {
    int nM, nN, nwg, G, c;
    __device__ void init(int M_, int N_, int G_, int c_) { nM = M_ / BM; nN = N_ / BM; nwg = nM * nN; G = G_; c = c_; }
    __device__ bool next(int i, Unit& u) const {
        const long L = (long)i * G + c; if (L >= nwg) return false;
        int wgid = (int)L; { const int q = nwg / NXCD, r = nwg % NXCD, xcd = wgid % NXCD, off = wgid / NXCD; wgid = (xcd < r ? xcd * (q + 1) : r * (q + 1) + (xcd - r) * q) + off; }
        const int nig = WGM * nN, gid = wgid / nig, fm = gid * WGM, gsz = (nM - fm) < WGM ? (nM - fm) : WGM;
        u.pm = fm + ((wgid % nig) % gsz); u.pn = (wgid % nig) / gsz; return true;
    }
};
template <class Epi>
__device__ __forceinline__ void epi_apply(const f32x4 (&acc)[2][2][4][2], const Unit& u, int wr, int wc, int fr, int fq, const Epi& E) {
#pragma unroll
    for (int ai = 0; ai < 2; ++ai)
#pragma unroll
        for (int m = 0; m < 4; ++m) { const int row = u.pm * BM + ai * HALF + wr * 64 + m * 16 + fr;
#pragma unroll
            for (int bj = 0; bj < 2; ++bj) {
                if constexpr (Epi::PERM) E.st8(row, u.pn * BM + bj * HALF + wc * 32 + 8 * fq, acc[ai][bj][m][0], acc[ai][bj][m][1]);
                else { E(row, u.pn * BM + bj * HALF + wc * 32 + 4 * fq, acc[ai][bj][m][0]); E(row, u.pn * BM + bj * HALF + wc * 32 + 16 + 4 * fq, acc[ai][bj][m][1]); }
            } }
}
template <class Epi, bool ALIGN_EPI, bool SP2, int AMAP>
__device__ __forceinline__ void gemm_phase(LAS unsigned char* lds, const Gemm g, const StaticOrder& S, const Epi& E, int tid_in) {
    static_assert(SP2, "only the SP2 loop is carried here");
    const int tid = tid_in, wid = __builtin_amdgcn_readfirstlane(tid >> 6), lane = tid & 63, wr = wid >> 2, wc = wid & 3, fr = lane & 15, fq = lane >> 4;
    const int K = g.K, nt = K / BK;
    unsigned voffA[2], voffB[2];
#pragma unroll
    for (int i = 0; i < 2; ++i) { int R, C; stage_rc(tid * 16 + i * 8192, R, C); const int Rb = Epi::PERM ? ((R & ~31) + perm32(R & 31)) : R;
        voffA[i] = (unsigned)(amap_row<AMAP>(R) * g.lda + C) * 2u; voffB[i] = (unsigned)(Rb * g.ldb + C) * 2u; }
    const size_t kstep = (size_t)(BK * 2);
    const size_t hA = g.hA, hB = g.hB, tA = g.tA, tB = g.tB;
    const unsigned ldsw = (unsigned)wid * 1024u;
    const int aoff = lds_byte(wr * 64 + fr, fq * 8), boff = lds_byte(wc * 32 + fr, fq * 8);
#define PG8_SA(b, h) (((b) * 2 + (h)) * HTB)
#define PG8_SB(b, h) ((4 + (b) * 2 + (h)) * HTB)
#define PG8_STAGE(bufoff, gbase, voff) do { _Pragma("unroll") for (int _i = 0; _i < 2; ++_i) \
        __builtin_amdgcn_global_load_lds((const unsigned*)((const char*)(gbase) + (voff)[_i]), (LAS unsigned*)(lds + (bufoff) + ldsw + _i * 8192), 16, 0, 0); } while (0)
#define PG8_LDA(dst, b, h) do { _Pragma("unroll") for (int m = 0; m < 4; ++m) _Pragma("unroll") for (int k = 0; k < 2; ++k) dst[m][k] = *(const LAS bf16x8*)(lds + PG8_SA(b, h) + aoff + m * 2048 + k * 1024); } while (0)
#define PG8_LDB(dst, b, h) do { _Pragma("unroll") for (int n = 0; n < 2; ++n) _Pragma("unroll") for (int k = 0; k < 2; ++k) dst[n][k] = *(const LAS bf16x8*)(lds + PG8_SB(b, h) + boff + n * 2048 + k * 1024); } while (0)
#define PG8_MMA(ai, bj, At, Bt) do { __builtin_amdgcn_s_setprio(1); _Pragma("unroll") for (int m = 0; m < 4; ++m) _Pragma("unroll") for (int n = 0; n < 2; ++n) _Pragma("unroll") for (int k = 0; k < 2; ++k) \
        acc[ai][bj][m][n] = __builtin_amdgcn_mfma_f32_16x16x32_bf16(Bt[n][k], At[m][k], acc[ai][bj][m][n], 0, 0, 0); __builtin_amdgcn_s_setprio(0); } while (0)
#define PG8_WAIT_V(n) asm volatile("s_waitcnt vmcnt(" #n ")" ::: "memory")
#define PG8_WAIT_L(n) asm volatile("s_waitcnt lgkmcnt(" #n ")" ::: "memory")
#define PG8_BAR __builtin_amdgcn_s_barrier()
#define PG8_SCHED __builtin_amdgcn_sched_barrier(0)
    Unit cur, nxt; int ui = 0;
    if (!S.next(0, cur)) return;
    f32x4 acc[2][2][4][2];
#pragma unroll
    for (int a = 0; a < 2; ++a)
#pragma unroll
        for (int b = 0; b < 2; ++b)
#pragma unroll
            for (int m = 0; m < 4; ++m)
#pragma unroll
                for (int n = 0; n < 2; ++n) acc[a][b][m][n] = (f32x4){0.f, 0.f, 0.f, 0.f};
    bf16x8 At[4][2], B0[2][2], B1[2][2];
    const char* cA = (const char*)g.A + (size_t)cur.pm * tA; const char* cB = (const char*)g.Bt + (size_t)cur.pn * tB;
    PG8_STAGE(PG8_SB(0, 0), cB, voffB); PG8_STAGE(PG8_SB(0, 1), cB + hB, voffB); PG8_STAGE(PG8_SA(0, 0), cA, voffA); PG8_STAGE(PG8_SA(0, 1), cA + hA, voffA);
    if (wr == 1) PG8_BAR;
    PG8_WAIT_V(2); PG8_BAR;
    PG8_STAGE(PG8_SB(1, 0), cB + kstep, voffB); PG8_STAGE(PG8_SA(1, 0), cA + kstep, voffA); PG8_STAGE(PG8_SB(1, 1), cB + hB + kstep, voffB);
    PG8_WAIT_V(6); PG8_BAR;
#pragma unroll 1
    for (;;) {
        const bool has_next = S.next(ui + 1, nxt);
        const char* nA = has_next ? (const char*)g.A + (size_t)nxt.pm * tA : cA; const char* nB = has_next ? (const char*)g.Bt + (size_t)nxt.pn * tB : cB;
#pragma unroll 1
        for (int t = 0; t < nt; t += 2) {
            const bool last = (t == nt - 2);
            const char* a1 = cA + (size_t)(t + 1) * kstep;
            const char* a2 = last ? nA : cA + (size_t)(t + 2) * kstep; const char* b2 = last ? nB : cB + (size_t)(t + 2) * kstep;
            const char* a3 = a2 + kstep; const char* b3 = b2 + kstep;
            PG8_LDB(B0, 0, 0); PG8_LDB(B1, 0, 1); PG8_SCHED; PG8_LDA(At, 0, 0); PG8_STAGE(PG8_SA(1, 1), a1 + hA, voffA);
            PG8_WAIT_V(8); PG8_WAIT_L(0); PG8_BAR; PG8_MMA(0, 0, At, B0); PG8_MMA(0, 1, At, B1); PG8_BAR; PG8_SCHED;
            PG8_LDA(At, 0, 1); PG8_STAGE(PG8_SB(0, 0), b2, voffB); PG8_STAGE(PG8_SB(0, 1), b2 + hB, voffB); PG8_STAGE(PG8_SA(0, 0), a2, voffA);
            PG8_WAIT_V(8); PG8_WAIT_L(0); PG8_BAR; PG8_MMA(1, 0, At, B0); PG8_MMA(1, 1, At, B1); PG8_BAR; PG8_SCHED;
            PG8_LDB(B0, 1, 0); PG8_LDB(B1, 1, 1); PG8_SCHED; PG8_LDA(At, 1, 0); PG8_STAGE(PG8_SA(0, 1), a2 + hA, voffA);
            PG8_WAIT_V(8); PG8_WAIT_L(0); PG8_BAR; PG8_MMA(0, 0, At, B0); PG8_MMA(0, 1, At, B1); PG8_BAR; PG8_SCHED;
            PG8_LDA(At, 1, 1); PG8_STAGE(PG8_SB(1, 0), b3, voffB); PG8_STAGE(PG8_SB(1, 1), b3 + hB, voffB); PG8_STAGE(PG8_SA(1, 0), a3, voffA);
            PG8_WAIT_V(8); PG8_WAIT_L(0); PG8_BAR; PG8_MMA(1, 0, At, B0); PG8_MMA(1, 1, At, B1); PG8_BAR; PG8_SCHED;
        }
        if constexpr (ALIGN_EPI) { if (wr == 0) PG8_BAR; }
        if constexpr (Epi::WHOLE) E.tile(acc, cur, wr, wc, fr, fq); else epi_apply(acc, cur, wr, wc, fr, fq, E);
        if (!has_next) break;
#pragma unroll
        for (int a = 0; a < 2; ++a)
#pragma unroll
            for (int b = 0; b < 2; ++b)
#pragma unroll
                for (int m = 0; m < 4; ++m)
#pragma unroll
                    for (int n = 0; n < 2; ++n) acc[a][b][m][n] = (f32x4){0.f, 0.f, 0.f, 0.f};
        cur = nxt; cA = nA; cB = nB; ++ui;
        if constexpr (ALIGN_EPI) { if (wr == 1) PG8_BAR; }
    }
    PG8_WAIT_V(0);
    if constexpr (!ALIGN_EPI) { if (wr == 0) PG8_BAR; }
    PG8_BAR;
#undef PG8_SA
#undef PG8_SB
#undef PG8_STAGE
#undef PG8_LDA
#undef PG8_LDB
#undef PG8_MMA
#undef PG8_WAIT_V
#undef PG8_WAIT_L
#undef PG8_BAR
#undef PG8_SCHED
}
}
template <class Epi>
__device__ __forceinline__ void gemm_mfma(const Fr& F, const bf16* A, int lda, const bf16* Bt, int ldb, int Mr, int N, int K, const Epi& E) {
    int tid = F.tid; asm volatile("" : "+v"(tid)); int kk = K; asm volatile("" : "+s"(kk));
    pg8::Gemm g{A, Bt, Mr, N, kk, lda, ldb, (size_t)512 * lda, (size_t)256 * lda, (size_t)512 * ldb, (size_t)256 * ldb}; pg8::StaticOrder S; S.init(Mr, N, F.nb, F.bid);
    pg8::gemm_phase<Epi, true, true, 0>(F.lds, g, S, E, tid);
    __syncthreads();
}
template <class Epi>
__device__ __forceinline__ void gemm_ffn_in(const Fr& F, const bf16* XNp, const bf16* Win  , const Epi& E) {
    int tid = F.tid; asm volatile("" : "+v"(tid)); int kk = D; asm volatile("" : "+s"(kk));
    pg8::Gemm g{XNp, Win, M, 2 * FF, kk, D, D, (size_t)512 * D, (size_t)4 * D * 2, (size_t)128 * D * 2, (size_t)FF * D * 2}; pg8::StaticOrder S; S.init(M, 2 * FF, F.nb, F.bid);
    pg8::gemm_phase<Epi, true, true, 1>(F.lds, g, S, E, tid);
    __syncthreads();
}
template <class Epi>
__device__ __forceinline__ void gemm_ffn_halo(const Fr& F, const bf16* XNp, const bf16* Win, const Epi& E) {
    int tid = F.tid; asm volatile("" : "+v"(tid)); int kk = D; asm volatile("" : "+s"(kk));
    pg8::Gemm g{XNp, Win, 512, FF, kk, D, D, (size_t)16384 * D * 2, (size_t)8192 * D * 2, (size_t)512 * D, (size_t)256 * D}; pg8::StaticOrder S; S.init(512, FF, F.nb, F.bid);
    pg8::gemm_phase<Epi, true, true, 2>(F.lds, g, S, E, tid);
    __syncthreads();
}

__device__ __forceinline__ void load_row_f32(const float* row, int lane, f32x4 (&v)[4]) {
#pragma unroll
    for (int j = 0; j < 4; ++j) v[j] = *(const f32x4*)(row + 4 * lane + 256 * j);
}
__device__ __forceinline__ void load_row_bf16(const bf16* row, int lane, f32x4 (&v)[4]) {
#pragma unroll
    for (int j = 0; j < 4; ++j) { const u32x2 w = *(const u32x2*)(row + 4 * lane + 256 * j); v[j] = (f32x4){bflo(w.x), bfhi(w.x), bflo(w.y), bfhi(w.y)}; }
}
__device__ __forceinline__ void store_row_bf16(bf16* row, int lane, const f32x4 (&v)[4]) {
#pragma unroll
    for (int j = 0; j < 4; ++j) { u32x2 w; w.x = pk2(v[j][0], v[j][1]); w.y = pk2(v[j][2], v[j][3]); *(u32x2*)(row + 4 * lane + 256 * j) = w; }
}
__device__ __forceinline__ float row_rinv(const f32x4 (&v)[4]) {
    float s = 0.f;
#pragma unroll
    for (int j = 0; j < 4; ++j) s += (v[j][0] * v[j][0] + v[j][1] * v[j][1]) + (v[j][2] * v[j][2] + v[j][3] * v[j][3]);
    return rsqrtf(wave_sum_dpp(s) * (1.f / D) + NORM_EPS);
}

template <bool XBF> __device__ __forceinline__ void load_row_x(const void* base, size_t row, int lane, f32x4 (&v)[4]) {
    if (XBF) load_row_bf16((const bf16*)base + row * D, lane, v); else load_row_f32((const float*)base + row * D, lane, v); }
template <bool XBF> __device__ __forceinline__ void store_row_x(void* base, size_t row, int lane, const f32x4 (&v)[4]) {
    if (XBF) store_row_bf16((bf16*)base + row * D, lane, v);
    else {
#pragma unroll
        for (int j = 0; j < 4; ++j) *(f32x4*)((float*)base + row * D + 4 * lane + 256 * j) = v[j]; } }
template <bool XBF> __device__ __forceinline__ void ph_a1(const Fr& F, const void* Xs, const float* g0, const float* mu  , int nrows, bf16* hn, bf16* xr, bf16* xk, bf16* xv) {
    const int lane = F.lane;
    f32x4 g[4], m0[4], m1[4], m2[4];
    load_row_f32(g0, lane, g); load_row_f32(mu, lane, m0); load_row_f32(mu + D, lane, m1); load_row_f32(mu + 2 * D, lane, m2);
#pragma unroll 1
    for (int run = F.gw; run < nrows / 4; run += F.ngw) {
        const int t0 = run * 4; const bool first = (t0 % T) == 0;
        f32x4 x[5][4];
        load_row_x<XBF>(Xs, (size_t)(first ? t0 : t0 - 1), lane, x[0]);
#pragma unroll
        for (int i = 0; i < 4; ++i) load_row_x<XBF>(Xs, (size_t)(t0 + i), lane, x[i + 1]);
        float ri[5];
#pragma unroll
        for (int i = 0; i < 5; ++i) ri[i] = row_rinv(x[i]);
        if (first) ri[0] = 0.f;
#pragma unroll
        for (int j = 0; j < 4; ++j) x[0][j] = x[0][j] * ri[0] * g[j];
#pragma unroll
        for (int i = 0; i < 4; ++i) {
            f32x4 o[4];
#pragma unroll
            for (int j = 0; j < 4; ++j) x[i + 1][j] = x[i + 1][j] * ri[i + 1] * g[j];
            const size_t ro = (size_t)(t0 + i) * D;
            if (hn) store_row_bf16(hn + ro, lane, x[i + 1]);
#pragma unroll
            for (int j = 0; j < 4; ++j) o[j] = x[i + 1][j] + (x[i][j] - x[i + 1][j]) * m0[j];
            store_row_bf16(xr + ro, lane, o);
#pragma unroll
            for (int j = 0; j < 4; ++j) o[j] = x[i + 1][j] + (x[i][j] - x[i + 1][j]) * m1[j];
            store_row_bf16(xk + ro, lane, o);
#pragma unroll
            for (int j = 0; j < 4; ++j) o[j] = x[i + 1][j] + (x[i][j] - x[i + 1][j]) * m2[j];
            store_row_bf16(xv + ro, lane, o);
        }
    }
}
__device__ __forceinline__ void ph_norm(const Fr& F, const bf16* Xs, const float* gv, int tok0, int nrows, bf16* out) {
    f32x4 g[4]; load_row_f32(gv, F.lane, g);
#pragma unroll 1
    for (int lr0 = F.gw * 4; lr0 < nrows; lr0 += F.ngw * 4) {
        f32x4 x[4][4];
#pragma unroll
        for (int i = 0; i < 4; ++i) load_row_bf16(Xs + (size_t)(tok0 + lr0 + i) * D, F.lane, x[i]);
#pragma unroll
        for (int i = 0; i < 4; ++i) { const float ri = row_rinv(x[i]);
#pragma unroll
            for (int j = 0; j < 4; ++j) x[i][j] = x[i][j] * ri * g[j];
            store_row_bf16(out + (size_t)(lr0 + i) * D, F.lane, x[i]); }
    }
}
__device__ __forceinline__ void ph_a3(const Fr& F, const bf16* PQ, int nrows, bf16* ALwa, bf16* ALg) {
    for (size_t idx = (size_t)F.bid * NTHREADS + F.tid; idx < (size_t)nrows * 64; idx += (size_t)F.nb * NTHREADS) {
        const int lr = (int)(idx >> 6), c = (int)(idx & 63) * 8; const bool first = (lr % T) == 0;
        int pc = -1, kind = 0;
        if (c < 64) { pc = c; kind = 0; } else if (c >= 128 && c < 192) { pc = 64 + (c - 128); kind = 1; } else if (c >= 256 && c < 416) { pc = 128 + (c - 256); kind = 2; }
        u32x4 o = (u32x4){0u, 0u, 0u, 0u};
        if (pc >= 0) { const u32x4 pv = *(const u32x4*)(PQ + (size_t)lr * 768 + pc); u32x4 qv = (u32x4){0u, 0u, 0u, 0u}; if (!first) qv = *(const u32x4*)(PQ + (size_t)(lr - 1) * 768 + 288 + pc);
#pragma unroll
            for (int e = 0; e < 4; ++e) { float s0 = bflo(pv[e]) + bflo(qv[e]), s1 = bfhi(pv[e]) + bfhi(qv[e]);
                if (kind == 0) { s0 = 1.f - 2.f * __builtin_amdgcn_rcpf(1.f + __builtin_amdgcn_exp2f(2.885390081777927f * s0)); s1 = 1.f - 2.f * __builtin_amdgcn_rcpf(1.f + __builtin_amdgcn_exp2f(2.885390081777927f * s1)); }
                else if (kind == 2) { s0 = __builtin_amdgcn_rcpf(1.f + __builtin_amdgcn_exp2f(-1.4426950408889634f * s0)); s1 = __builtin_amdgcn_rcpf(1.f + __builtin_amdgcn_exp2f(-1.4426950408889634f * s1)); }
                o[e] = pk2(s0, s1); } }
        if (c < 256) *(u32x4*)(ALwa + (size_t)lr * 256 + c) = o; else *(u32x4*)(ALg + (size_t)lr * 256 + (c - 256)) = o;
    }
}
constexpr int SC_TC = 32, SC_VEC = SC_TC * 64 * 4, SC_BUF = 5 * SC_VEC + SC_TC * 32 * 4;
constexpr int S5_BUF = 5 * SC_TC * 64 * 4 + SC_TC * 32 * 4;
__device__ __forceinline__ float red8(float v) { v += dpp_mov<0xB1>(v); v += dpp_mov<0x4E>(v); v += dpp_mov<0x141>(v); return v; }
__device__ __forceinline__ void ph_scan5(const Fr& F, const bf16* Rg, const bf16* Kg, const bf16* Vg, const bf16* Lg, const bf16* Ag, const float* k_k, const float* k_a, const float* r_k, unsigned short* Yg, float* CTg) {
    const GAS bf16* Rb = (const GAS bf16*)Rg; const GAS bf16* Kb = (const GAS bf16*)Kg; const GAS bf16* Vb = (const GAS bf16*)Vg; const GAS bf16* Lb = (const GAS bf16*)Lg; const GAS bf16* Ab = (const GAS bf16*)Ag;
    GAS unsigned short* Y = (GAS unsigned short*)Yg; GAS float* CT = (GAS float*)CTg;
    LAS unsigned char* lds = F.lds; LAS float* Yl = (LAS float*)(lds + 2 * S5_BUF);
    const int lane = F.lane, wave = F.wave, tid = F.tid;
    const bool comp = wave < 4;
    const int rloc = (wave & 3) * 8 + (lane >> 3), kj = (lane & 7) * 8;
    LAS float* yl_base = Yl + rloc * 4 + ((lane & 7) >> 1);
    const int hw = wave & 3, ht = tid & 255;
#pragma unroll 1
    for (int u = F.bid; u < NB * NH * 2; u += F.nb) {
        int hv = u & 1, bh = u >> 1;
        if (F.nb == 256) { const int x = F.bid & 7, y = F.bid >> 3; bh = x * 16 + (y >> 1); hv = y & 1; }
        const int bl = bh / NH, h = bh % NH, c = h * 64 + lane;
        const int half = lane >> 5, cp = lane & 31;
        const f32x2_t kkc2 = *(const f32x2_t*)(k_k + h * 64 + 2 * cp), kac2 = *(const f32x2_t*)(k_a + h * 64 + 2 * cp), rkc2 = *(const f32x2_t*)(r_k + h * 64 + 2 * cp);
        const size_t base = (size_t)(bl * T) * D + c;
        f32x4 Sa = (f32x4){0.f, 0.f, 0.f, 0.f}, Sb = Sa; float py = 0.f;
        unsigned gr[4], gk[4], gv[4], gl[4], ga[4];
#define S5_ISSUE(t0) do { const size_t ub = (size_t)__builtin_amdgcn_readfirstlane((int)(((bl * T) + (t0) + hw * 8) * (D / 64) + h)) * 64;     \
            const GAS unsigned* rp = (const GAS unsigned*)(Rb + ub); const GAS unsigned* kp = (const GAS unsigned*)(Kb + ub); const GAS unsigned* vp = (const GAS unsigned*)(Vb + ub); const GAS unsigned* lp = (const GAS unsigned*)(Lb + ub); const GAS unsigned* ap = (const GAS unsigned*)(Ab + ub); \
            _Pragma("unroll") for (int i = 0; i < 4; ++i) { const int o = (2 * i + half) * (D / 2) + cp; gr[i] = rp[o]; gk[i] = kp[o]; gv[i] = vp[o]; gl[i] = lp[o]; ga[i] = ap[o]; } } while (0)
#define S5_PREP(b, tcur) do { LAS float* Wv = (LAS float*)(lds + (b) * S5_BUF); _Pragma("unroll") for (int i = 0; i < 4; ++i) { const int s = hw * 8 + 2 * i + half; \
            const f32x2_t r2 = {bflo(gr[i]), bfhi(gr[i])}, k2 = {bflo(gk[i]), bfhi(gk[i])}, v2 = {bflo(gv[i]), bfhi(gv[i])}, l2 = {bflo(gl[i]), bfhi(gl[i])}, a2 = {bflo(ga[i]), bfhi(ga[i])}; \
            const f32x2_t kk2 = k2 * kkc2, sq2 = kk2 * kk2; const float hs = half_sum_r13(sq2[0] + sq2[1]); \
            const float sA = __builtin_bit_cast(float, __builtin_amdgcn_readlane(__builtin_bit_cast(int, hs), 31)), sB = __builtin_bit_cast(float, __builtin_amdgcn_readlane(__builtin_bit_cast(int, hs), 63)); \
            const float nrs = -__builtin_amdgcn_rsqf(fmaxf(half ? sB : sA, 1e-24f)); const f32x2_t nkn2 = kk2 * nrs; \
            const f32x2_t kmd2 = k2 * ((a2 - 1.f) * kac2 + 1.f), t2 = r2 * kmd2 * rkc2; const float ctv = half_sum_r13(t2[0] + t2[1]); \
            if (hv == 0 && cp == 31) CT[(size_t)(bl * T + (tcur) + s) * 16 + h] = ctv; \
            f32x2_t dec2; dec2[0] = __builtin_amdgcn_exp2f(l2[0] * 1.4426950408889634f); dec2[1] = __builtin_amdgcn_exp2f(l2[1] * 1.4426950408889634f); \
            *(LAS f32x2_t*)(Wv + s * 64 + 2 * cp) = dec2; *(LAS f32x2_t*)(Wv + SC_TC * 64 + s * 64 + 2 * cp) = nkn2; *(LAS f32x2_t*)(Wv + 2 * SC_TC * 64 + s * 64 + 2 * cp) = nkn2 * (-a2); \
            *(LAS f32x2_t*)(Wv + 3 * SC_TC * 64 + s * 64 + 2 * cp) = kmd2; *(LAS f32x2_t*)(Wv + 4 * SC_TC * 64 + s * 64 + 2 * cp) = r2; \
            if ((cp >> 4) == hv) *(LAS f32x2_t*)(Wv + 5 * SC_TC * 64 + s * 32 + ((2 * cp) & 31)) = v2; } } while (0)
#define S5_YOUT(b, tprev) do { const int s = ht >> 3, rr = (ht & 7) * 4; const LAS f32x4* yp = (const LAS f32x4*)(Yl + (b) * 4096 + s * 128 + rr * 4); const f32x4 y0 = yp[0], y1 = yp[1], y2 = yp[2], y3 = yp[3]; \
            const f32x4 yv = {(y0[0] + y0[1]) + (y0[2] + y0[3]), (y1[0] + y1[1]) + (y1[2] + y1[3]), (y2[0] + y2[1]) + (y2[2] + y2[3]), (y3[0] + y3[1]) + (y3[2] + y3[3])}; \
            const f32x2_t y01 = {yv[0], yv[1]}, y23 = {yv[2], yv[3]}; const h16x2_t h01 = __builtin_convertvector(y01, h16x2_t), h23 = __builtin_convertvector(y23, h16x2_t); \
            u32x2 w; w.x = __builtin_bit_cast(unsigned, h01); w.y = __builtin_bit_cast(unsigned, h23); \
            *(GAS u32x2*)(Y + (size_t)(bl * T + (tprev) + s) * D + h * 64 + hv * 32 + rr) = w; } while (0)
        __syncthreads();
        if (!comp) { S5_ISSUE(0); S5_PREP(0, 0); S5_ISSUE(SC_TC); }
        __syncthreads();
#pragma unroll 1
        for (int t0 = 0; t0 < T; t0 += SC_TC) {
            const int b = (t0 / SC_TC) & 1;
            if (comp) {
                const LAS float* Wv = (const LAS float*)(lds + b * S5_BUF);
#define S5_LOAD(s, w0, w1, a0, a1, b0, b1, k0, k1, r0, r1, v_) do { \
                w0 = *(const LAS f32x4*)(Wv + (s) * 64 + kj); w1 = *(const LAS f32x4*)(Wv + (s) * 64 + kj + 4); a0 = *(const LAS f32x4*)(Wv + SC_TC * 64 + (s) * 64 + kj); a1 = *(const LAS f32x4*)(Wv + SC_TC * 64 + (s) * 64 + kj + 4); \
                b0 = *(const LAS f32x4*)(Wv + 2 * SC_TC * 64 + (s) * 64 + kj); b1 = *(const LAS f32x4*)(Wv + 2 * SC_TC * 64 + (s) * 64 + kj + 4); k0 = *(const LAS f32x4*)(Wv + 3 * SC_TC * 64 + (s) * 64 + kj); k1 = *(const LAS f32x4*)(Wv + 3 * SC_TC * 64 + (s) * 64 + kj + 4); \
                r0 = *(const LAS f32x4*)(Wv + 4 * SC_TC * 64 + (s) * 64 + kj); r1 = *(const LAS f32x4*)(Wv + 4 * SC_TC * 64 + (s) * 64 + kj + 4); v_ = Wv[5 * SC_TC * 64 + (s) * 32 + rloc]; } while (0)
                f32x4 w0, w1, a0, a1, b0, b1, k0, k1, r0, r1; float vv;
                S5_LOAD(0, w0, w1, a0, a1, b0, b1, k0, k1, r0, r1, vv);
#pragma unroll
                for (int s = 0; s < SC_TC; ++s) {
                    f32x4 nw0 = w0, nw1 = w1, na0 = a0, na1 = a1, nb0 = b0, nb1 = b1, nk0 = k0, nk1 = k1, nr0 = r0, nr1 = r1; float nv = vv;
                    if (s + 1 < SC_TC) S5_LOAD(s + 1, nw0, nw1, na0, na1, nb0, nb1, nk0, nk1, nr0, nr1, nv);
                    float sa; { f32x2_t p = __builtin_shufflevector(Sa, Sa, 0, 1) * __builtin_shufflevector(a0, a0, 0, 1);
                        p = __builtin_elementwise_fma(__builtin_shufflevector(Sa, Sa, 2, 3), __builtin_shufflevector(a0, a0, 2, 3), p);
                        p = __builtin_elementwise_fma(__builtin_shufflevector(Sb, Sb, 0, 1), __builtin_shufflevector(a1, a1, 0, 1), p);
                        p = __builtin_elementwise_fma(__builtin_shufflevector(Sb, Sb, 2, 3), __builtin_shufflevector(a1, a1, 2, 3), p); sa = p[0] + p[1]; }
                    f32x4 ta = Sa * w0, tb = Sb * w1;
                    sa += dpp_mov<0xB1>(sa); py += dpp_mov<0xB1>(py);
                    ta = ta + vv * k0; tb = tb + vv * k1;
                    sa += dpp_mov<0x4E>(sa);
                    sa += dpp_mov<0x141>(sa);
                    Sa = ta + sa * b0; Sb = tb + sa * b1;
                    if (s > 0) yl_base[b * 4096 + (s - 1) * 128] = py;
                    { f32x2_t p = __builtin_shufflevector(Sa, Sa, 0, 1) * __builtin_shufflevector(r0, r0, 0, 1);
                        p = __builtin_elementwise_fma(__builtin_shufflevector(Sa, Sa, 2, 3), __builtin_shufflevector(r0, r0, 2, 3), p);
                        p = __builtin_elementwise_fma(__builtin_shufflevector(Sb, Sb, 0, 1), __builtin_shufflevector(r1, r1, 0, 1), p);
                        p = __builtin_elementwise_fma(__builtin_shufflevector(Sb, Sb, 2, 3), __builtin_shufflevector(r1, r1, 2, 3), p); py = p[0] + p[1]; }
                    w0 = nw0; w1 = nw1; a0 = na0; a1 = na1; b0 = nb0; b1 = nb1; k0 = nk0; k1 = nk1; r0 = nr0; r1 = nr1; vv = nv;
                }
#undef S5_LOAD
                { py += dpp_mov<0xB1>(py); yl_base[b * 4096 + 31 * 128] = py; py = 0.f; }
            } else {
                if (t0 > 0) S5_YOUT(b ^ 1, t0 - SC_TC);
                if (t0 + SC_TC < T) {
                    asm volatile("" : "+v"(gr[0]), "+v"(gr[1]), "+v"(gr[2]), "+v"(gr[3]), "+v"(gk[0]), "+v"(gk[1]), "+v"(gk[2]), "+v"(gk[3]), "+v"(gv[0]), "+v"(gv[1]), "+v"(gv[2]), "+v"(gv[3]) :: "memory");
                    asm volatile("" : "+v"(gl[0]), "+v"(gl[1]), "+v"(gl[2]), "+v"(gl[3]), "+v"(ga[0]), "+v"(ga[1]), "+v"(ga[2]), "+v"(ga[3]) :: "memory");
                    S5_PREP(b ^ 1, t0 + SC_TC);
                    if (t0 + 2 * SC_TC < T) S5_ISSUE(t0 + 2 * SC_TC);
                }
            }
            __syncthreads();
        }
        if (!comp) S5_YOUT(1, T - SC_TC);
#undef S5_ISSUE
#undef S5_PREP
#undef S5_YOUT
    }
    __syncthreads();
}
__device__ __forceinline__ void ph_a6(const Fr& F, const unsigned short* Yh, const bf16* Vb, const bf16* Gb, const float* CT, const float* lw, const float* lb, bf16* out, int nrows) {
    const int lane = F.lane, c0 = lane * 16;
    float lwv[16], lbv[16];
#pragma unroll
    for (int e = 0; e < 16; ++e) { lwv[e] = lw[c0 + e]; lbv[e] = lb[c0 + e]; }
#pragma unroll 1
    for (int lr0 = F.gw * 2; lr0 < nrows; lr0 += F.ngw * 2) {
        u32x4 yw[2][2], vw[2][2], gw[2][2]; float cb[2];
#pragma unroll
        for (int i = 0; i < 2; ++i) { const size_t ro = (size_t)(lr0 + i) * D + c0;
            yw[i][0] = *(const u32x4*)(Yh + ro); yw[i][1] = *(const u32x4*)(Yh + ro + 8); vw[i][0] = *(const u32x4*)(Vb + ro); vw[i][1] = *(const u32x4*)(Vb + ro + 8);
            gw[i][0] = *(const u32x4*)(Gb + ro); gw[i][1] = *(const u32x4*)(Gb + ro + 8); cb[i] = CT[(size_t)(lr0 + i) * 16 + (lane >> 2)]; }
#pragma unroll
        for (int i = 0; i < 2; ++i) {
            float y[16], v[16], g[16];
#pragma unroll
            for (int q = 0; q < 2; ++q)
#pragma unroll
                for (int e = 0; e < 4; ++e) { const unsigned uy = yw[i][q][e], uv = vw[i][q][e], ug = gw[i][q][e]; const h16x2_t p = __builtin_bit_cast(h16x2_t, uy);
                    y[8 * q + 2 * e] = (float)p[0]; y[8 * q + 2 * e + 1] = (float)p[1]; v[8 * q + 2 * e] = bflo(uv); v[8 * q + 2 * e + 1] = bfhi(uv); g[8 * q + 2 * e] = bflo(ug); g[8 * q + 2 * e + 1] = bfhi(ug); }
            float s = 0.f;
#pragma unroll
            for (int e = 0; e < 16; ++e) s += y[e];
            s += dpp_mov<0xB1>(s); s += dpp_mov<0x4E>(s);
            const float mean = s * (1.f / 64.f); float q = 0.f;
#pragma unroll
            for (int e = 0; e < 16; ++e) { const float d = y[e] - mean; q += d * d; }
            q += dpp_mov<0xB1>(q); q += dpp_mov<0x4E>(q);
            const float rstd = rsqrtf(q * (1.f / 64.f) + LNX_EPS);
            u32x4 o0, o1; float o[16];
#pragma unroll
            for (int e = 0; e < 16; ++e) o[e] = ((y[e] - mean) * rstd * lwv[e] + lbv[e] + cb[i] * v[e]) * g[e];
#pragma unroll
            for (int e = 0; e < 4; ++e) { o0[e] = pk2(o[2 * e], o[2 * e + 1]); o1[e] = pk2(o[8 + 2 * e], o[8 + 2 * e + 1]); }
            const size_t ro = (size_t)(lr0 + i) * D + c0;
            *(u32x4*)(out + ro) = o0; *(u32x4*)(out + ro + 8) = o1;
        }
    }
}
template <bool SBF, bool DBF> __device__ __forceinline__ void ph_resid(const Fr& F, const void* Xs, void* Xd, const bf16* m, const float* g1v, const float* g2v, int tok0, int nrows, bf16* XN, const float* g3v = nullptr, bf16* XN3 = nullptr, float* rinv_out = nullptr) {
    const int lane = F.lane; f32x4 g1[4], g2[4], g3[4]; load_row_f32(g1v, lane, g1); if (g2v) load_row_f32(g2v, lane, g2); if (g3v) load_row_f32(g3v, lane, g3);
#pragma unroll 1
    for (int lr0 = F.gw * 2; lr0 < nrows; lr0 += F.ngw * 2) {
        f32x4 mv[2][4], x[2][4];
#pragma unroll
        for (int i = 0; i < 2; ++i) { load_row_bf16(m + (size_t)(lr0 + i) * D, lane, mv[i]); load_row_x<SBF>(Xs, (size_t)(tok0 + lr0 + i), lane, x[i]); }
#pragma unroll
        for (int i = 0; i < 2; ++i) {
            const float ri = row_rinv(mv[i]);
#pragma unroll
            for (int j = 0; j < 4; ++j) x[i][j] = x[i][j] + mv[i][j] * ri * g1[j];
            store_row_x<DBF>(Xd, (size_t)(tok0 + lr0 + i), lane, x[i]);
            if (rinv_out && !g2v) { const float r2 = row_rinv(x[i]); if (lane == 0) rinv_out[tok0 + lr0 + i] = r2; }
            if (g2v) { const float r2 = row_rinv(x[i]); if (rinv_out && lane == 0) rinv_out[tok0 + lr0 + i] = r2;
#pragma unroll
                for (int j = 0; j < 4; ++j) x[i][j] = x[i][j] * r2;
                if (g3v) { f32x4 y3[4];
#pragma unroll
                    for (int j = 0; j < 4; ++j) y3[j] = x[i][j] * g3[j];
                    store_row_bf16(XN3 + (size_t)(tok0 + lr0 + i) * D, lane, y3); }
#pragma unroll
                for (int j = 0; j < 4; ++j) x[i][j] = x[i][j] * g2[j];
                store_row_bf16(XN + (size_t)(tok0 + lr0 + i) * D, lane, x[i]); }
        }
    }
}
__device__ __forceinline__ void ph_k3(const Fr& F, const float* down  , const float* gv, const float* ct, const float* st, int tok0, bf16* ckv, bf16* KR, int nrows) {
    const int lane = F.lane; const f32x4 g = *(const f32x4*)(gv + 4 * lane);
    for (int lr = F.gw; lr < nrows; lr += F.ngw) {
        const float* row = down + (size_t)lr * 512; const f32x4 x = *(const f32x4*)(row + 4 * lane);
        const float ss = wave_sum_dpp((x[0] * x[0] + x[1] * x[1]) + (x[2] * x[2] + x[3] * x[3])); const float ri = rsqrtf(ss * (1.f / 256.f) + NORM_EPS);
        u32x2 w; w.x = pk2(x[0] * ri * g[0], x[1] * ri * g[1]); w.y = pk2(x[2] * ri * g[2], x[3] * ri * g[3]);
        *(u32x2*)(ckv + (size_t)lr * 256 + 4 * lane) = w;
        if (lane < 16) { const int t = (tok0 + lr) % T; const float x1 = row[256 + lane], x2 = row[272 + lane], cs = ct[t * 16 + lane], sn = st[t * 16 + lane];
            KR[(size_t)(tok0 + lr) * 32 + lane] = (bf16)f2bf(x1 * cs - x2 * sn); KR[(size_t)(tok0 + lr) * 32 + 16 + lane] = (bf16)f2bf(x1 * sn + x2 * cs); }
    }
}
__device__ __forceinline__ void ph_b3(const Fr& F, const float* raw  , const float* gv, bf16* cq, int nrows) {
    const int lane = F.lane;
    for (int lr = F.gw; lr < nrows; lr += F.ngw) {
        float x[6], s = 0.f;
#pragma unroll
        for (int i = 0; i < 6; ++i) { x[i] = raw[(size_t)lr * 512 + lane + 64 * i]; s += x[i] * x[i]; }
        const float ri = rsqrtf(wave_sum_dpp(s) * (1.f / 384.f) + NORM_EPS);
#pragma unroll
        for (int i = 0; i < 6; ++i) cq[(size_t)lr * 384 + lane + 64 * i] = (bf16)f2bf(x[i] * ri * gv[lane + 64 * i]);
    }
}
typedef float f32x16 __attribute__((ext_vector_type(16)));
typedef short s16x8 __attribute__((ext_vector_type(8)));
typedef short s16x4 __attribute__((ext_vector_type(4)));
constexpr int AT_KST = 208, AT_VST = 136, AT_KB = 64 * AT_KST, AT_BUF = AT_KB + 64 * AT_VST;
__device__ __forceinline__ void attn_qk(const LAS unsigned char* kb, const int r, const int hh, const s16x8 (&qf)[6], const float mrun, f32x16& s0, f32x16& s1) {
    s16x8 ka[12];
#pragma unroll
    for (int s = 0; s < 6; ++s) {
        ka[2 * s] = *(const LAS s16x8*)(kb + r * AT_KST + (16 * s + 8 * hh) * 2);
        ka[2 * s + 1] = *(const LAS s16x8*)(kb + (32 + r) * AT_KST + (16 * s + 8 * hh) * 2);
    }
#pragma unroll
    for (int i = 0; i < 16; ++i) { s0[i] = -mrun; s1[i] = -mrun; }
    __builtin_amdgcn_sched_barrier(0);
#pragma unroll
    for (int s = 0; s < 6; ++s) {
        s0 = __builtin_amdgcn_mfma_f32_32x32x16_bf16(ka[2 * s], qf[s], s0, 0, 0, 0);
        s1 = __builtin_amdgcn_mfma_f32_32x32x16_bf16(ka[2 * s + 1], qf[s], s1, 0, 0, 0);
    }
    __builtin_amdgcn_sched_barrier(0);
}
#define AT_MAX4(m, v, b) asm("v_max3_f32 %0, %0, %1, %2\n\tv_max3_f32 %0, %0, %3, %4" : "+v"(m) : "v"(v[b]), "v"(v[b + 1]), "v"(v[b + 2]), "v"(v[b + 3]))
#define AT_MAX8(m, v, b) asm("v_max3_f32 %0, %0, %1, %2\n\tv_max3_f32 %0, %0, %3, %4\n\tv_max3_f32 %0, %0, %5, %6\n\tv_max3_f32 %0, %0, %7, %8" : "+v"(m) : "v"(v[b]), "v"(v[b + 1]), "v"(v[b + 2]), "v"(v[b + 3]), "v"(v[b + 4]), "v"(v[b + 5]), "v"(v[b + 6]), "v"(v[b + 7]))
__device__ __forceinline__ float attn_rowmax(const f32x16& n0, const f32x16& n1) {
    float m = fmaxf(n0[15], n1[15]);
    AT_MAX8(m, n0, 0); AT_MAX8(m, n0, 8); AT_MAX8(m, n1, 0); AT_MAX8(m, n1, 8);
    float xa = m, xb = m; asm("s_nop 1\n\tv_permlane32_swap_b32 %0, %1" : "+v"(xa), "+v"(xb)); return fmaxf(xa, xb);
}
__device__ __forceinline__ void attn_rescale(const float mt, const bool first, f32x16& n0, f32x16& n1, f32x16& o0, f32x16& o1, float& mrun, float& lrun) {
    const bool upd = first || (mt > 8.f);
    if (__any(upd)) {
        const float delta = upd ? mt : 0.f, corr = first ? 1.f : __builtin_amdgcn_exp2f(-delta); mrun += delta; lrun *= corr;
#pragma unroll
        for (int i = 0; i < 16; ++i) { n0[i] -= delta; n1[i] -= delta; o0[i] *= corr; o1[i] *= corr; }
    }
}
#define AT_SB __builtin_amdgcn_sched_barrier(0)
__device__ __forceinline__ void attn_interval(const LAS unsigned char* kbn, const LAS unsigned char* vbc, const int r, const int hh, const s16x8 (&qf)[6], const bool nxt,
                                              f32x16& c0, f32x16& c1, f32x16& n0, f32x16& n1, f32x16& o0, f32x16& o1, float& mrun, float& lrun) {
    constexpr bool NXT = true;
    s16x8 kf[12]; s16x4 vl[8], vh[8]; u32x4 pw[4]; float acca = 0.f, accb = 0.f; float mt = 0.f;
    const LAS unsigned char* kp0 = kbn + r * AT_KST + 16 * hh; const LAS unsigned char* kp1 = kp0 + 32 * AT_KST;
    const LAS unsigned char* vp0 = vbc + r * AT_VST + 8 * hh;  const LAS unsigned char* vp1 = vp0 + 32 * AT_VST;
#define AT_KRD(s_) do { kf[2 * (s_)] = *(const LAS s16x8*)(kp0 + 32 * (s_)); kf[2 * (s_) + 1] = *(const LAS s16x8*)(kp1 + 32 * (s_)); } while (0)
#define AT_VRD(q_) do { const int kc_ = (((q_) >> 1) * 32 + 16 * ((q_) & 1)) * 2; vl[2 * (q_)] = *(const LAS s16x4*)(vp0 + kc_); vh[2 * (q_)] = *(const LAS s16x4*)(vp0 + kc_ + 16); \
                        vl[2 * (q_) + 1] = *(const LAS s16x4*)(vp1 + kc_); vh[2 * (q_) + 1] = *(const LAS s16x4*)(vp1 + kc_ + 16); } while (0)
#define AT_EXP(e_) do { if ((e_) < 16) c0[(e_) & 15] = __builtin_amdgcn_exp2f(c0[(e_) & 15]); else if ((e_) < 32) c1[(e_) & 15] = __builtin_amdgcn_exp2f(c1[(e_) & 15]); } while (0)
#define AT_PACK2(q_, h_) do { _Pragma("unroll") for (int e_ = 2 * (h_); e_ < 2 * (h_) + 2; ++e_) pw[(q_)][e_] = ((q_) >> 1) ? pk2(c1[8 * ((q_) & 1) + 2 * e_], c1[8 * ((q_) & 1) + 2 * e_ + 1]) : pk2(c0[8 * ((q_) & 1) + 2 * e_], c0[8 * ((q_) & 1) + 2 * e_ + 1]); } while (0)
    if (NXT) {
        AT_KRD(0); AT_KRD(1);
#pragma unroll
        for (int i = 0; i < 16; ++i) { n0[i] = -mrun; n1[i] = -mrun; }
    }
    AT_SB;
#pragma unroll
    for (int g = 0; g < 12; ++g) {
        const int s = g >> 1;
        if (g == 0) __builtin_amdgcn_s_setprio(3);
        if (g == 6) __builtin_amdgcn_s_setprio(2);
        if (g & 1) n1 = __builtin_amdgcn_mfma_f32_32x32x16_bf16(kf[2 * s + 1], qf[s], n1, 0, 0, 0);
        else       n0 = __builtin_amdgcn_mfma_f32_32x32x16_bf16(kf[2 * s], qf[s], n0, 0, 0, 0);
        AT_SB;
        if ((g & 1) && s < 4) AT_KRD(s + 2);
        if (g == 8) AT_VRD(0);
        if (g == 10) AT_VRD(1);
        const int e0 = g < 8 ? 3 * g : 24 + 2 * (g - 8), ne = g < 8 ? 3 : 2;
#pragma unroll
        for (int e = e0; e < e0 + ne; ++e) AT_EXP(e);
        if (g == 10) AT_PACK2(0, 0);
        if (g == 11) AT_PACK2(0, 1);
        AT_SB;
    }
#pragma unroll
    for (int g = 0; g < 8; ++g) {
        const int q = g >> 1, h2 = g & 1;
        if (g == 0) __builtin_amdgcn_s_setprio(1);
        if (g == 4) __builtin_amdgcn_s_setprio(0);
        if (h2) { const s16x8 v1 = __builtin_shufflevector(vl[2 * q + 1], vh[2 * q + 1], 0, 1, 2, 3, 4, 5, 6, 7); o1 = __builtin_amdgcn_mfma_f32_32x32x16_bf16(v1, __builtin_bit_cast(s16x8, pw[q]), o1, 0, 0, 0); }
        else    { const s16x8 v0 = __builtin_shufflevector(vl[2 * q], vh[2 * q], 0, 1, 2, 3, 4, 5, 6, 7);         o0 = __builtin_amdgcn_mfma_f32_32x32x16_bf16(v0, __builtin_bit_cast(s16x8, pw[q]), o0, 0, 0, 0); }
        AT_SB;
        if (g == 0) AT_VRD(2);
        if (g == 2) AT_VRD(3);
        if (q < 3) AT_PACK2(q + 1, h2);
#pragma unroll
        for (int i = 4 * h2; i < 4 * h2 + 4; ++i) {
            const float cv = (q >> 1) ? c1[8 * (q & 1) + i] : c0[8 * (q & 1) + i];
            if (i & 1) asm("v_add_f32 %0, %0, %1" : "+v"(accb) : "v"(cv)); else asm("v_add_f32 %0, %0, %1" : "+v"(acca) : "v"(cv));
        }
        if (g == 0) mt = fmaxf(n0[15], n1[15]);
        if (q < 2) AT_MAX4(mt, n0, 8 * q + 4 * h2); else AT_MAX4(mt, n1, 8 * (q - 2) + 4 * h2);
        AT_SB;
    }
    lrun += acca + accb;
    if (nxt) {
        float xa = mt, xb = mt; asm("s_nop 1\n\tv_permlane32_swap_b32 %0, %1" : "+v"(xa), "+v"(xb)); mt = fmaxf(xa, xb);
        attn_rescale(mt, false, n0, n1, o0, o1, mrun, lrun);
    }
#undef AT_KRD
#undef AT_VRD
#undef AT_EXP
#undef AT_PACK2
}
__device__ __forceinline__ void ph_attn_mfma(const Fr& F, const bf16* Qg, const bf16* KNg, const bf16* KRg, const bf16* VTg, int tok0, bf16* Og) {
    const GAS bf16* Q = (const GAS bf16*)Qg; const GAS bf16* KN = (const GAS bf16*)KNg; const GAS bf16* KR = (const GAS bf16*)KRg; const GAS bf16* VT = (const GAS bf16*)VTg; GAS bf16* O = (GAS bf16*)Og;
    LAS unsigned char* lds = F.lds;
    const int tid = F.tid, lane = F.lane, wave = F.wave, r = lane & 31, hh = lane >> 5;
    const int k_key = tid >> 3, k_ch = tid & 7, r_key = tid >> 2, r_ch = tid & 3;
    const unsigned offK = (unsigned)(k_key * D + k_ch * 8) * 2u, offR = (unsigned)(r_key * 32 + r_ch * 8) * 2u, offV = (unsigned)tid * 16u;
#pragma unroll 1
    for (int u = F.bid; u < NB * NH * 8; u += F.nb) {
        int bh = u >> 3, pp = u & 7;
        if (F.nb == 256) { const int x = F.bid & 7, y = F.bid >> 3; bh = (u >> 8) * 32 + x * 4 + (y >> 3); pp = y & 7; }
        const int bl = bh / NH, h = bh % NH;
        const int gtok0 = tok0 + bl * T;
#pragma unroll 1
        for (int hp = 0; hp < 2; ++hp) {
            const int qb = hp ? pp : 15 - pp, ntiles = 4 * qb + 4, mychunk = 4 * qb + (wave >> 1);
            int tq = tid; asm volatile("" : "+v"(tq));
            const int lrow = bl * T + 256 * qb + (tq >> 1 & ~31) + (tq & 31);
            s16x8 qf[6];
#pragma unroll
            for (int s = 0; s < 6; ++s) qf[s] = *(const GAS s16x8*)(Q + (size_t)lrow * 1536 + h * 96 + 16 * s + 8 * (tq >> 5 & 1));
            f32x16 o0, o1;
#pragma unroll
            for (int i = 0; i < 16; ++i) { o0[i] = 0.f; o1[i] = 0.f; }
            float mrun = 0.f, lrun = 0.f;
            u32x4 gk0, gr0, gv0;
#define AT_ISSUE(j, gk, gr, gv) do { const int gt = __builtin_amdgcn_readfirstlane(gtok0 + 64 * (j));        \
                         gk = *(const GAS u32x4*)((const GAS char*)(KN + (size_t)gt * D + h * 64) + offK); \
                         if (tid < 256) gr = *(const GAS u32x4*)((const GAS char*)(KR + (size_t)gt * 32) + offR); \
                         gv = *(const GAS u32x4*)((const GAS char*)(VT + ((size_t)h * (M / 64) + (gt >> 6)) * 4096) + offV); } while (0)
#define AT_WRITE(bo, gk, gr, gv) do { LAS unsigned char* kb = lds + (bo); *(LAS u32x4*)(kb + k_key * AT_KST + k_ch * 16) = gk; \
                         if (tid < 256) *(LAS u32x4*)(kb + r_key * AT_KST + 128 + r_ch * 16) = gr; \
                         LAS unsigned char* vb = kb + AT_KB + k_key * AT_VST + k_ch * 16; *(LAS u32x2*)(vb) = (u32x2){gv.x, gv.y}; *(LAS u32x2*)(vb + 8) = (u32x2){gv.z, gv.w}; } while (0)
            { u32x4 gk1, gr1, gv1;
              AT_ISSUE(0, gk0, gr0, gv0); AT_ISSUE(1, gk1, gr1, gv1);
              AT_WRITE(0, gk0, gr0, gv0); AT_WRITE(AT_BUF, gk1, gr1, gv1); AT_ISSUE(2, gk0, gr0, gv0); }
            __syncthreads();
            f32x16 sa0, sa1, sb0, sb1;
            attn_qk(lds, r, hh, qf, 0.f, sa0, sa1);
            { const float mt = attn_rowmax(sa0, sa1); attn_rescale(mt, true, sa0, sa1, o0, o1, mrun, lrun); }
            unsigned b0 = 0, b1 = AT_BUF, b2 = 2 * AT_BUF;
#pragma unroll 1
            for (int j = 0; j < ntiles; j += 2) {
                if (j + 2 < ntiles) AT_WRITE(b2, gk0, gr0, gv0);
                if (j + 3 < ntiles) AT_ISSUE(j + 3, gk0, gr0, gv0);
                if (j <= mychunk) attn_interval(lds + b1, lds + b0 + AT_KB, r, hh, qf, j + 1 <= mychunk, sa0, sa1, sb0, sb1, o0, o1, mrun, lrun);
                __syncthreads();
                if (j + 3 < ntiles) AT_WRITE(b0, gk0, gr0, gv0);
                if (j + 4 < ntiles) AT_ISSUE(j + 4, gk0, gr0, gv0);
                if (j + 1 <= mychunk) attn_interval(lds + b2, lds + b1 + AT_KB, r, hh, qf, j + 2 <= mychunk, sb0, sb1, sa0, sa1, o0, o1, mrun, lrun);
                __syncthreads();
                const unsigned t0 = b0; b0 = b2; b2 = b1; b1 = t0;
            }
#undef AT_ISSUE
#undef AT_WRITE
            const float lt = lrun + __shfl_xor(lrun, 32), il = 1.f / lt;
            int to = tid; asm volatile("" : "+v"(to));
            GAS bf16* op = O + (size_t)(bl * T + 256 * qb + (to >> 1 & ~31) + (to & 31)) * D + h * 64 + 4 * (to >> 5 & 1);
#pragma unroll
            for (int g = 0; g < 4; ++g) {
                u32x2 w0, w1; w0.x = pk2(o0[4 * g] * il, o0[4 * g + 1] * il); w0.y = pk2(o0[4 * g + 2] * il, o0[4 * g + 3] * il);
                w1.x = pk2(o1[4 * g] * il, o1[4 * g + 1] * il); w1.y = pk2(o1[4 * g + 2] * il, o1[4 * g + 3] * il);
                *(GAS u32x2*)(op + 8 * g) = w0; *(GAS u32x2*)(op + 32 + 8 * g) = w1;
            }
        }
    }
}

constexpr int NSTEPS = 1 + (6 + 3) + (7 + 3) + (4 + 3) + (4 + 3);
#define SB(i) ((bf16*)(ws + SLOT(i)))
#define SF(i) ((float*)(ws + SLOT(i)))
#define P0 ((bf16*)(ws + 100 * MiB))
#define P1 ((bf16*)(ws + 164 * MiB))
#define P2 ((bf16*)(ws + 228 * MiB))
#define P3 ((bf16*)(ws + 292 * MiB))
#define P4 ((bf16*)(ws + 356 * MiB))
#define P5 ((bf16*)(ws + 420 * MiB))
#define PE ((bf16*)(ws + 484 * MiB))
#define PQf ((bf16*)(ws + 252 * MiB))
#define PCT ((float*)(ws + 500 * MiB))
#define SSQ ((float*)(ws + WS_SSQ))
#define SSQX(k) ((float*)(ws + WS_CTL + WS_SSQX))
#define RESID(SF, DF, SQ_, src, dst, gain, use, sq) EpiResid<SF, DF, SQ_>{src, dst, gain, (float*)(ws + WS_RSLOT), (unsigned*)(ws + WS_CTL + WS_RCNT), (unsigned)(use), sq, F.lds}
#define XSTREAM (L == 3 ? XB2 : XB)
#define XB ((bf16*)X)
#define XB2 ((bf16*)(ws + 382 * MiB))
#define kvn SB(0)
#define down SF(1)
#define ckv SB(2)
#define hn SB(0)
#define cqr SF(1)
#define cq SB(2)
#define Qb SB(3)
#define Ob SB(5)
#define mbB SB(0)
#define Hfull SB(0)
#define Ghalo SF(6)
__global__ void __launch_bounds__(NTHREADS, 2) mk_fwd(P p) {
    extern __shared__ __attribute__((aligned(16))) unsigned char lds_raw[];
    Fr F0; F0.lds = (LAS unsigned char*)lds_raw; F0.tid = threadIdx.x; F0.lane = F0.tid & 63; F0.wave = __builtin_amdgcn_readfirstlane(F0.tid >> 6);
    F0.bid = blockIdx.x; F0.nb = gridDim.x; F0.gw = F0.bid * NWAVES + F0.wave; F0.ngw = F0.nb * NWAVES;
    const Fr& F = F0;
    volatile LAS unsigned* misc = (volatile LAS unsigned*)(F.lds + LDS_BYTES - 64);
    if (F.tid < 16) misc[F.tid] = 0u;
    __syncthreads();
    unsigned char* ws0 = p.ws;
    LAS unsigned long long* ptab = (LAS unsigned long long*)(F0.lds + LDS_BYTES - 512);
    if (F0.tid < 30) ptab[F0.tid] = (unsigned long long)p.in[F0.tid];
    if (F0.tid == 30) ptab[30] = (unsigned long long)p.X;
    __syncthreads();
    XcdBarrier bar; bar.bar = (unsigned*)(ws0 + WS_CTL) + 4096; bar.x = 0; bar.st = misc;
    if (p.s_hi - p.s_lo > 1) bar = xcd_barrier_post((unsigned*)(ws0 + WS_CTL) + 4096, misc);
    int step = 0;
#define IN(k) ((const float*)(const GAS float*)ldptr(ptab, (k)))
#define RUN(body) do { if (p.s_lo <= step && step < p.s_hi) { { Fr F = F0; asm volatile("" : "+v"(F.tid)); F.lane = F.tid & 63; F.wave = __builtin_amdgcn_readfirstlane(F.tid >> 6); asm volatile("" : "+s"(F.bid)); F.gw = F.bid * NWAVES + F.wave; GAS unsigned char* ws = (GAS unsigned char*)ws0; asm volatile("" : "+s"(ws)); const float* ct = (const float*)(ws + WS_COS); const float* st = (const float*)(ws + WS_SIN); bf16* XN = (bf16*)(ws + A_XN); bf16* KN = (bf16*)(ws + A_KN); bf16* VT = (bf16*)(ws + A_VT); bf16* KR = (bf16*)(ws + A_KR); float* X = (float*)(GAS float*)ldptr(ptab, 30); const float* ng = IN(1) + (size_t)L * 4 * D; const float* Xs = (L == 0) ? IN(0) : (const float*)X; (void)ct; (void)st; (void)XN; (void)KN; (void)VT; (void)KR; (void)ng; (void)Xs; body; } if (step + 1 < p.s_hi) xcd_barrier(bar); } ++step; } while (0)


    { const int L = 0; RUN({ prologue(F, ptab, (unsigned char*)ws); ph_a1<false>(F, IN(0), ng, IN(6), M, P0, P4, P5, P3); }); }

    for (int L = 0; L < 4; ++L) {
        if (L < 2) {
            const int i = L;
            if (L == 1) RUN(ph_a1<true>(F, XB, ng, IN(6) + (size_t)i * 6 * D, M, (bf16*)nullptr, P4, P5, P3));
            RUN({ if (L == 0) gemm_mfma(F, P0, D, (bf16*)(ws + W_LD) + (size_t)i * 768 * D, D, M, 768, D, EpiBf16{P1, 768, 768});
                  else gemm_mfma(F, XB, D, (bf16*)(ws + W_LD) + (size_t)i * 768 * D, D, M, 768, D, EpiBf16RS{P1, 768, SSQX(0)});
                  gemm_mfma(F, P4, D, (bf16*)(ws + W_RKV) + (size_t)(i * 3 + 0) * D * D, D, M, D, D, EpiBf16{P2, D, D}); });
            RUN({ ph_a3(F, P1, M, P1 + (size_t)M * 768, PE);
                  gemm_mfma(F, P5, D, (bf16*)(ws + W_RKV) + (size_t)(i * 3 + 1) * D * D, D, M, D, D, EpiBf16{P4, D, D});
                  gemm_mfma(F, P3, D, (bf16*)(ws + W_RKV) + (size_t)(i * 3 + 2) * D * D, D, M, D, D, EpiBf16{P0, D, D}); });
            RUN({ gemm_mfma(F, P1 + (size_t)M * 768, 256, (bf16*)(ws + W_W2) + (size_t)i * D * 128, 128, M, D, 128, EpiSigT<true>{P5, IN(8) + (size_t)i * D});
                  gemm_mfma(F, P1 + (size_t)M * 768 + 128, 256, (bf16*)(ws + W_A2) + (size_t)i * D * 128, 128, M, D, 128, EpiSigT<false>{P3, IN(11) + (size_t)i * D}); });
            RUN(ph_scan5(F, P2, P4, P0, P5, P3, IN(16) + (size_t)i * D, IN(17) + (size_t)i * D, IN(18) + (size_t)i * D, (unsigned short*)P1, PCT));
            RUN(gemm_mfma(F, PE, 256, (bf16*)(ws + W_G2) + (size_t)i * D * 256, 256, M, D, 256, EpiA6{(const unsigned short*)P1, P0, PCT, IN(19) + (size_t)i * D, IN(20) + (size_t)i * D, P1, F.lds}));
            RUN({ if (L == 0) gemm_mfma(F, P1, D, (bf16*)(ws + W_OA) + (size_t)i * D * D, D, M, D, D, RESID(true, false, true, (const void*)IN(0), (void*)XB, ng + D, 1, SSQX(0)));
                  else gemm_mfma(F, P1, D, (bf16*)(ws + W_OA) + (size_t)i * D * D, D, M, D, D, RESID(false, false, true, (const void*)XB, (void*)XB, ng + D, 3, SSQX(1))); });
        } else {
            const int j = L - 2;
            if (L == 2) {
                RUN({ gemm_mfma(F, XB, D, (bf16*)(ws + W_KVD), D, M, 512, D, EpiKvd{P2, KR, IN(24), ct, st, SSQX(4), F.lds});
                      gemm_mfma(F, XB, D, (bf16*)(ws + W_QD) + (size_t)j * 512 * D, D, M, 512, D, EpiCqRaw{P1, SSQX(4 + j), SSQ + (size_t)j * M, 384}); });
                RUN({ gemm_mfma(F, P2, 256, (bf16*)(ws + W_KVUK), 256, M, D, 256, EpiBf16{KN, D, D});
                      gemm_mfma(F, (bf16*)(ws + W_KVUV), 256, P2, 256, D, M, 256, EpiVT{VT});
                      gemm_mfma(F, P1, 512, (bf16*)(ws + W_QU) + (size_t)j * 1536 * 384, 384, M, 1536, 384, EpiQRope{PQf, ct, st, 0, SSQ + (size_t)j * M}); });
            } else {
                RUN(gemm_mfma(F, XB, D, (bf16*)(ws + W_QD) + (size_t)j * 512 * D, D, M, 512, D, EpiCqRaw{P1, SSQX(4 + j), SSQ + (size_t)j * M, 384}));
                RUN(gemm_mfma(F, P1, 512, (bf16*)(ws + W_QU) + (size_t)j * 1536 * 384, 384, M, 1536, 384, EpiQRope{PQf, ct, st, 0, SSQ + (size_t)j * M}));
            }
            RUN(ph_attn_mfma(F, PQf, KN, KR, VT, 0, P0));
            RUN({ if (L == 3) gemm_mfma(F, P0, D, (bf16*)(ws + W_OM) + (size_t)j * D * D, D, M, D, D, RESID(false, false, true, (const void*)XB, (void*)XB2, ng + D, 7, SSQX(3)));
                  else gemm_mfma(F, P0, D, (bf16*)(ws + W_OM) + (size_t)j * D * D, D, M, D, D, RESID(false, false, true, (const void*)XB, (void*)XB, ng + D, 5, SSQX(2))); });
        }
        RUN({ gemm_ffn_halo(F, XSTREAM, (bf16*)(ws + W_FIN) + (size_t)L * 2 * FF * D, EpiF32{Ghalo, FF, FF}); if (L < 3) prologue_side(F, (unsigned char*)ws, L + 1); });
        RUN(gemm_ffn_in(F, XSTREAM, (bf16*)(ws + W_FIN) + (size_t)L * 2 * FF * D, EpiFfn{Hfull, IN(3) + (size_t)L * 3 * FF, IN(4) + (size_t)L * FF, Ghalo, SSQX(L)}));
        RUN({ if (L == 0) gemm_mfma(F, Hfull, FF, (bf16*)(ws + W_FOUT) + (size_t)L * D * FF, FF, M, D, FF, RESID(false, false, true, (const void*)XB, (void*)XB, ng + 3 * D, 2, SSQX(0)));
              else if (L == 1) gemm_mfma(F, Hfull, FF, (bf16*)(ws + W_FOUT) + (size_t)L * D * FF, FF, M, D, FF, RESID(false, false, true, (const void*)XB, (void*)XB, ng + 3 * D, 4, SSQX(4)));
              else if (L == 2) gemm_mfma(F, Hfull, FF, (bf16*)(ws + W_FOUT) + (size_t)L * D * FF, FF, M, D, FF, RESID(false, false, true, (const void*)XB, (void*)XB, ng + 3 * D, 6, SSQX(5)));
              else gemm_mfma(F, Hfull, FF, (bf16*)(ws + W_FOUT) + (size_t)L * D * FF, FF, M, D, FF, RESID(false, true, false, (const void*)XB2, (void*)X, ng + 3 * D, 8, (float*)nullptr)); });
    }
#undef RUN
}

extern "C" void kernel_launch(void* const* d_in, const int* in_sizes, int n_in, void* d_out, int out_size, void* d_ws, size_t ws_size, hipStream_t stream) {
    static int grid = 0;
    if (grid == 0) {
        if (n_in != 30 || out_size != M * D || ws_size < WS_NEED) { fprintf(stderr, "kernel_launch: unexpected shapes n_in %d out %d ws %zu\n", n_in, out_size, ws_size); grid = -1; return; }
        int dev = 0, cus = 0;
        if (hipGetDevice(&dev) != hipSuccess || hipDeviceGetAttribute(&cus, hipDeviceAttributeMultiprocessorCount, dev) != hipSuccess) { grid = -1; return; }
        if (hipFuncSetAttribute((const void*)mk_fwd, hipFuncAttributeMaxDynamicSharedMemorySize, LDS_BYTES) != hipSuccess) { fprintf(stderr, "kernel_launch: hipFuncSetAttribute failed\n"); grid = -1; return; }
        int per_cu = 0;
        (void)hipOccupancyMaxActiveBlocksPerMultiprocessor(&per_cu, (const void*)mk_fwd, NTHREADS, LDS_BYTES);
        (void)hipGetLastError();
        grid = cus;
    }
    if (grid < 0) return;
    (void)hipMemsetAsync((char*)d_ws + WS_CTL, 0, CTL_BYTES, stream);
    P p{};
    for (int i = 0; i < 30; ++i) p.in[i] = (const float*)d_in[i];
    p.X = (float*)d_out; p.ws = (unsigned char*)d_ws;
#if ONE_LAUNCH
    p.s_lo = 0; p.s_hi = NSTEPS;
    hipLaunchKernelGGL(mk_fwd, dim3(grid), dim3(NTHREADS), LDS_BYTES, stream, p);
#else
    for (int s = 0; s < NSTEPS; ++s) { p.s_lo = s; p.s_hi = s + 1; hipLaunchKernelGGL(mk_fwd, dim3(grid), dim3(NTHREADS), LDS_BYTES, stream, p); }
#endif
}
```
